# Optimizing an MI355X kernel written in HIP

```python
import jax, jax.numpy as jnp
from jax import lax
import numpy as np

D_MODEL = 2048
BATCH = 1
SEQ = 8192
DEPTH = 4

CHUNK = 64
N_MIXERS = 2
HEAD_DIM = 128
N_HEADS = D_MODEL // HEAD_DIM
Q_BLOCK = 128
POOL_WINDOWS = (2, 4, 8, 16)
N_POOL_GROUPS = len(POOL_WINDOWS)
POOL_GROUP = D_MODEL // N_POOL_GROUPS
D_FF = -(-8 * D_MODEL // (3 * 256)) * 256
N_FOX_LAYERS = (DEPTH + N_MIXERS - 1) // N_MIXERS
N_POOL_LAYERS = DEPTH // N_MIXERS
RMS_EPS = 1e-6
NEG_INF = -1e30

kernel_name = "fox_pool_hybrid_encoder"


def rmsnorm(x, g):
    xf = x.astype(jnp.float32)
    y = xf * lax.rsqrt(jnp.mean(xf * xf, axis=-1, keepdims=True) + RMS_EPS)
    return (y * g.astype(jnp.float32)).astype(x.dtype)


def forgetting_attention(h, w_in, b_f, g_q, g_k, w_out):
    B, S, D = h.shape
    proj = jnp.einsum('bsd,de->bse', h, w_in)
    q = proj[..., :D].reshape(B, S, N_HEADS, HEAD_DIM)
    k = proj[..., D:2 * D].reshape(B, S, N_HEADS, HEAD_DIM)
    v = proj[..., 2 * D:3 * D].reshape(B, S, N_HEADS, HEAD_DIM)
    f_logit = proj[..., 3 * D:]
    q = rmsnorm(q, g_q)
    k = rmsnorm(k, g_k)
    log_f = jax.nn.log_sigmoid((f_logit + b_f).astype(jnp.float32))
    c = jnp.cumsum(log_f, axis=1).transpose(0, 2, 1)
    nb = S // Q_BLOCK
    q_blocks = q.reshape(B, nb, Q_BLOCK, N_HEADS, HEAD_DIM).transpose(1, 0, 2, 3, 4)
    c_blocks = c.reshape(B, N_HEADS, nb, Q_BLOCK).transpose(2, 0, 1, 3)
    starts = jnp.arange(nb) * Q_BLOCK
    k_pos = jnp.arange(S)
    scale = HEAD_DIM ** -0.5

    def block(args):
        qb, cb, start = args
        s = jnp.einsum('bqhd,bkhd->bhqk', qb, k).astype(jnp.float32) * scale
        s = s + (cb[..., :, None] - c[..., None, :])
        q_pos = start + jnp.arange(Q_BLOCK)
        s = jnp.where(q_pos[:, None] >= k_pos[None, :], s, NEG_INF)
        p = jax.nn.softmax(s, axis=-1).astype(v.dtype)
        return jnp.einsum('bhqk,bkhd->bqhd', p, v)

    o = lax.map(block, (q_blocks, c_blocks, starts))
    o = o.transpose(1, 0, 2, 3, 4).reshape(B, S, D)
    return jnp.einsum('bsd,de->bse', o, w_out)


def multiscale_pool(h, w, b, scale):
    B, S, D = h.shape
    hf = h.astype(jnp.float32)
    cs = jnp.concatenate([jnp.zeros((B, 1, D), jnp.float32), jnp.cumsum(hf, axis=1)], axis=1)
    t = jnp.arange(S)
    means = []
    for g, win in enumerate(POOL_WINDOWS):
        csg = cs[..., g * POOL_GROUP:(g + 1) * POOL_GROUP]
        lo = jnp.maximum(t + 1 - win, 0)
        cnt = (t + 1 - lo).astype(jnp.float32)
        means.append((csg[:, t + 1] - csg[:, lo]) / cnt[None, :, None])
    y = (jnp.concatenate(means, axis=-1) - hf).astype(h.dtype)
    y = jnp.einsum('bsgc,gce->bsge', y.reshape(B, S, N_POOL_GROUPS, POOL_GROUP), w).reshape(B, S, D)
    return (y + b) * scale


def swiglu(h, w_gu, w_down):
    gu = jnp.einsum('bsd,df->bsf', h, w_gu)
    gate, up = gu[..., :D_FF], gu[..., D_FF:]
    return jnp.einsum('bsf,fd->bsd', jax.nn.silu(gate) * up, w_down)


def setup_inputs(seed: int = 0) -> dict:
    key = jax.random.key(seed)
    ks = jax.random.split(key, 13)
    f32 = jnp.float32
    D = D_MODEL
    x = jax.random.normal(ks[0], (BATCH, SEQ, D), f32)
    mix_norm_g = 1.0 + 0.02 * jax.random.normal(ks[1], (DEPTH, D), f32)
    ffn_norm_g = 1.0 + 0.02 * jax.random.normal(ks[2], (DEPTH, D), f32)
    fox_w_in = jax.random.normal(ks[3], (N_FOX_LAYERS, D, 3 * D + N_HEADS), f32) * D ** -0.5
    fox_b_f = 2.0 + 0.5 * jax.random.normal(ks[4], (N_FOX_LAYERS, N_HEADS), f32)
    fox_q_norm_g = 1.0 + 0.02 * jax.random.normal(ks[5], (N_FOX_LAYERS, HEAD_DIM), f32)
    fox_k_norm_g = 1.0 + 0.02 * jax.random.normal(ks[6], (N_FOX_LAYERS, HEAD_DIM), f32)
    fox_w_out = jax.random.normal(ks[7], (N_FOX_LAYERS, D, D), f32) * D ** -0.5
    pool_w = jax.random.normal(ks[8], (N_POOL_LAYERS, N_POOL_GROUPS, POOL_GROUP, POOL_GROUP), f32) * POOL_GROUP ** -0.5
    pool_b = 0.01 * jax.random.normal(ks[9], (N_POOL_LAYERS, D), f32)
    pool_scale = 1.0 + 0.02 * jax.random.normal(ks[10], (N_POOL_LAYERS, D), f32)
    ffn_w_gate_up = jax.random.normal(ks[11], (DEPTH, D, 2 * D_FF), f32) * D ** -0.5
    ffn_w_down = jax.random.normal(ks[12], (DEPTH, D_FF, D), f32) * D_FF ** -0.5
    return {"x": x, "mix_norm_g": mix_norm_g, "ffn_norm_g": ffn_norm_g,
            "fox_w_in": fox_w_in, "fox_b_f": fox_b_f, "fox_q_norm_g": fox_q_norm_g,
            "fox_k_norm_g": fox_k_norm_g, "fox_w_out": fox_w_out,
            "pool_w": pool_w, "pool_b": pool_b, "pool_scale": pool_scale,
            "ffn_w_gate_up": ffn_w_gate_up, "ffn_w_down": ffn_w_down}


def reference(x, mix_norm_g, ffn_norm_g, fox_w_in, fox_b_f, fox_q_norm_g, fox_k_norm_g,
              fox_w_out, pool_w, pool_b, pool_scale, ffn_w_gate_up, ffn_w_down):
    for i in range(DEPTH):
        j = i // N_MIXERS
        h = rmsnorm(x, mix_norm_g[i])
        if i % N_MIXERS == 0:
            x = x + forgetting_attention(h, fox_w_in[j], fox_b_f[j], fox_q_norm_g[j],
                                         fox_k_norm_g[j], fox_w_out[j])
        else:
            x = x + multiscale_pool(h, pool_w[j], pool_b[j], pool_scale[j])
        h = rmsnorm(x, ffn_norm_g[i])
        x = x + swiglu(h, ffn_w_gate_up[i], ffn_w_down[i])
    return x
```

```cpp
#include <hip/hip_runtime.h>
#include <hip/hip_cooperative_groups.h>
#include <cstdio>
#include <cstdint>
namespace cg = cooperative_groups;

#define LAS __attribute__((address_space(3)))
typedef unsigned short bf16_t;
typedef short bf16x8 __attribute__((ext_vector_type(8)));
typedef short s16x4 __attribute__((ext_vector_type(4)));
typedef float f32x4 __attribute__((ext_vector_type(4)));
typedef float f32x16 __attribute__((ext_vector_type(16)));
typedef unsigned u32x4 __attribute__((ext_vector_type(4)));
typedef unsigned u32x2 __attribute__((ext_vector_type(2)));

constexpr int S = 8192, DM = 2048, NH = 16, HD = 128, FF = 5632, NLAYER = 4;
constexpr int WIN_LD = 3 * DM + NH;
constexpr float RMS_EPS = 1e-6f;
constexpr float LOG2E = 1.4426950408889634f;
constexpr float QSCALE = 0.08838834764831845f * 1.4426950408889634f;
constexpr int NPART = 32;

constexpr size_t MiB = 1u << 20;
constexpr size_t WS_PART = 1 * MiB;
constexpr size_t WS_LOGF = 2 * MiB;
constexpr size_t WS_CB = 3 * MiB;
constexpr size_t WS_XB = 588 * MiB;
constexpr size_t WS_QKV = 36 * MiB;
constexpr size_t WS_O = 624 * MiB;
constexpr size_t WS_H = 164 * MiB;
constexpr size_t WS_WIN = 256 * MiB;
constexpr size_t WS_WOUT = 304 * MiB;
constexpr size_t WS_WPOOL = 320 * MiB;
constexpr size_t WS_WGU = 324 * MiB;
constexpr size_t WS_WDN = 500 * MiB;
constexpr size_t WS_END = 660 * MiB;
constexpr int ALD = DM + 64;

constexpr int STAGE_BYTES = 131072;
constexpr int LDS_BYTES = 147456;
constexpr int NTHREADS = 512;

__device__ __forceinline__ unsigned cvt_pk_bf16(float lo, float hi) { unsigned r; asm volatile("v_cvt_pk_bf16_f32 %0, %1, %2" : "=v"(r) : "v"(lo), "v"(hi)); return r; }
typedef float f32x2_t __attribute__((ext_vector_type(2))); typedef __bf16 bf16x2_t __attribute__((ext_vector_type(2)));
__device__ __forceinline__ unsigned cvtpk_s(float lo, float hi) { f32x2_t v = {lo, hi}; bf16x2_t b = __builtin_convertvector(v, bf16x2_t); return __builtin_bit_cast(unsigned, b); }
__device__ __forceinline__ float bf2f(unsigned short h) { return __uint_as_float((unsigned)h << 16); }
__device__ __forceinline__ float wave_sum(float v) {
#pragma unroll
    for (int o = 1; o < 64; o <<= 1) v += __shfl_xor(v, o);
    return v;
}
__device__ __forceinline__ float row_rstd(const float* part, int row) {
    const f32x4* p = (const f32x4*)(part + (size_t)row * NPART); f32x4 s = p[0];
#pragma unroll
    for (int i = 1; i < NPART / 4; ++i) s += p[i];
    const float t = (s.x + s.y) + (s.z + s.w);
    return __builtin_amdgcn_rsqf(t * (1.0f / DM) + RMS_EPS);
}

namespace pg8 {
constexpr int BM = 256, BK = 64, HALF = 128, HTB = HALF * BK * 2, NXCD = 8, WGM = 8;
__host__ __device__ __forceinline__ int lds_byte(int r, int c) { const int st = (r >> 4) * 2 + (c >> 5), rr = r & 15, cc = c & 31, ob = rr * 64 + cc * 2; return st * 1024 + (ob ^ (((ob >> 9) & 1) << 5)); }
__host__ __device__ __forceinline__ void stage_rc(int b, int& R, int& C) { const int st = b / 1024, sb = b % 1024, swz = sb ^ (((sb >> 9) & 1) << 5); R = (st >> 1) * 16 + swz / 64; C = (st & 1) * 32 + (swz % 64) / 2; }
__host__ __device__ __forceinline__ int perm32(int rho) { const int n = rho >> 4, i = rho & 15; return 8 * (i >> 2) + 4 * n + (i & 3); }

struct Unit { int pm, pn; };
struct Gemm { const char* A; const char* B; int lda, ldbN, K, nM, nN, gs, gm; unsigned agrp, bgrp; };
__device__ __forceinline__ const char* tileA(const Gemm& g, const Unit& u) { return g.A + (size_t)u.pm * 256 * g.lda * 2 + (size_t)(u.pn >> g.gs) * g.agrp; }
__device__ __forceinline__ const char* tileB(const Gemm& g, const Unit& u) { return g.B + (size_t)(u.pn >> g.gs) * g.bgrp + (size_t)(u.pn & g.gm) * 256 * 64; }

struct StaticOrder {
    int nM, nN, nwg, G, c;
    __device__ void init(int nM_, int nN_, int G_, int c_) { nM = nM_; nN = nN_; nwg = nM * nN; G = G_; c = c_; }
    __device__ bool next(int i, Unit& u) const {
        const long L = (long)i * G + c; if (L >= nwg) return false;
        int wgid = (int)L; { const int q = nwg / NXCD, r = nwg % NXCD, xcd = wgid % NXCD, off = wgid / NXCD; wgid = (xcd < r ? xcd * (q + 1) : r * (q + 1) + (xcd - r) * q) + off; }
        const int nig = WGM * nN, gid = wgid / nig, fm = gid * WGM, gsz = (nM - fm) < WGM ? (nM - fm) : WGM;
        u.pm = fm + ((wgid % nig) % gsz); u.pn = (wgid % nig) / gsz; return true;
    }
};

template <class Epi, bool ALIGN_EPI>
__device__ __forceinline__ void gemm_phase(LAS unsigned char* lds, const Gemm g, int G, int cid, const Epi& E) {
    int tid = threadIdx.x; asm volatile("" : "+v"(tid));
    const int wid = __builtin_amdgcn_readfirstlane(tid >> 6), lane = tid & 63, wr = wid >> 2, wc = wid & 3, fr = lane & 15, fq = lane >> 4;
    const int K = g.K, nt = K / BK;
    StaticOrder S; S.init(g.nM, g.nN, G, cid);
    unsigned voffA[2], voffB[2];
#pragma unroll
    for (int i = 0; i < 2; ++i) { int R, C; stage_rc(tid * 16 + i * 8192, R, C); const int Rb = (R & ~31) + perm32(R & 31);
        voffA[i] = (unsigned)(R * g.lda + C) * 2u; voffB[i] = (unsigned)((C >> 5) * g.ldbN + Rb) * 64u + (unsigned)(C & 31) * 2u; }
    const size_t kA = (size_t)(BK * 2), kB = (size_t)2 * g.ldbN * 64;
    const size_t hA = (size_t)HALF * g.lda * 2, hB = (size_t)HALF * 64;
    const unsigned ldsw = (unsigned)wid * 1024u;
    const int aoff = lds_byte(wr * 64 + fr, fq * 8), boff = lds_byte(wc * 32 + fr, fq * 8);
#define PG8_SA(b, h) (((b) * 2 + (h)) * HTB)
#define PG8_SB(b, h) ((4 + (b) * 2 + (h)) * HTB)
#define PG8_STAGE(bufoff, gbase, voff) do { _Pragma("unroll") for (int _i = 0; _i < 2; ++_i) \
        __builtin_amdgcn_global_load_lds((const unsigned*)((const char*)(gbase) + (voff)[_i]), (LAS unsigned*)(lds + (bufoff) + ldsw + _i * 8192), 16, 0, 0); } while (0)
#define PG8_LDA(dst, b, h) do { _Pragma("unroll") for (int m = 0; m < 4; ++m) _Pragma("unroll") for (int k = 0; k < 2; ++k) dst[m][k] = *(const LAS bf16x8*)(lds + PG8_SA(b, h) + aoff + m * 2048 + k * 1024); } while (0)
#define PG8_LDB(dst, b, h) do { _Pragma("unroll") for (int n = 0; n < 2; ++n) _Pragma("unroll") for (int k = 0; k < 2; ++k) dst[n][k] = *(const LAS bf16x8*)(lds + PG8_SB(b, h) + boff + n * 2048 + k * 1024); } while (0)
#define PG8_MMA(ai, bj, At, Bt) do { __builtin_amdgcn_s_setprio(1); _Pragma("unroll") for (int m = 0; m < 4; ++m) _Pragma("unroll") for (int n = 0; n < 2; ++n) _Pragma("unroll") for (int k = 0; k < 2; ++k) \
        acc[ai][bj][m][n] = __builtin_amdgcn_mfma_f32_16x16x32_bf16(Bt[n][k], At[m][k], acc[ai][bj][m][n], 0, 0, 0); __builtin_amdgcn_s_setprio(0); } while (0)
#define PG8_WAIT_V(n) asm volatile("s_waitcnt vmcnt(" #n ")" ::: "memory")
#define PG8_WAIT_L(n) asm volatile("s_waitcnt lgkmcnt(" #n ")" ::: "memory")
#define PG8_BAR __builtin_amdgcn_s_barrier()
#define PG8_SCHED __builtin_amdgcn_sched_barrier(0)
    Unit cur, nxt; int ui = 0;
    if (!S.next(0, cur)) return;
    LAS float* rtab = (LAS float*)(lds + 8 * HTB);
#define PG8_RTAB_FILL() do { if constexpr (Epi::ROWSCALE) { if (tid < 256) rtab[(ui & 1) * 256 + tid] = row_rstd(E.part, cur.pm * 256 + tid); } } while (0)
    f32x4 rl0[NPART / 4];
#pragma unroll
    for (int i = 0; i < NPART / 4; ++i) rl0[i] = (f32x4){0.f, 0.f, 0.f, 0.f};
    if constexpr (Epi::ROWSCALE) { if (tid < 256) { const f32x4* p_ = (const f32x4*)(E.part + (size_t)(cur.pm * 256 + tid) * NPART);
#pragma unroll
        for (int i = 0; i < NPART / 4; ++i) rl0[i] = p_[i]; } }
    f32x4 acc[2][2][4][2];
#pragma unroll
    for (int a = 0; a < 2; ++a)
#pragma unroll
        for (int b = 0; b < 2; ++b)
#pragma unroll
            for (int m = 0; m < 4; ++m)
#pragma unroll
                for (int n = 0; n < 2; ++n) acc[a][b][m][n] = (f32x4){0.f, 0.f, 0.f, 0.f};
    bf16x8 At[4][2], B0[2][2], B1[2][2];
    const char* cA = tileA(g, cur); const char* cB = tileB(g, cur);
    PG8_STAGE(PG8_SB(0, 0), cB, voffB); PG8_STAGE(PG8_SB(0, 1), cB + hB, voffB); PG8_STAGE(PG8_SA(0, 0), cA, voffA); PG8_STAGE(PG8_SA(0, 1), cA + hA, voffA);
    if (wr == 1) PG8_BAR;
    PG8_WAIT_V(2); PG8_BAR;
    PG8_STAGE(PG8_SB(1, 0), cB + kB, voffB); PG8_STAGE(PG8_SA(1, 0), cA + kA, voffA); PG8_STAGE(PG8_SB(1, 1), cB + hB + kB, voffB);
    PG8_WAIT_V(6); PG8_BAR;
    if constexpr (Epi::ROWSCALE) { if (tid < 256) { f32x4 s_ = rl0[0];
#pragma unroll
        for (int i = 1; i < NPART / 4; ++i) s_ += rl0[i];
        rtab[tid] = __builtin_amdgcn_rsqf(((s_.x + s_.y) + (s_.z + s_.w)) * (1.0f / DM) + RMS_EPS); } }
    for (;;) {
        const bool has_next = S.next(ui + 1, nxt);
        const char* nA = has_next ? tileA(g, nxt) : cA; const char* nB = has_next ? tileB(g, nxt) : cB;
        for (int t = 0; t < nt; t += 2) {
            const bool last = (t == nt - 2);
            const char* a1 = cA + (size_t)(t + 1) * kA;
            const char* a2 = last ? nA : cA + (size_t)(t + 2) * kA; const char* b2 = last ? nB : cB + (size_t)(t + 2) * kB;
            const char* a3 = a2 + kA; const char* b3 = b2 + kB;
            PG8_LDB(B0, 0, 0); PG8_LDB(B1, 0, 1); PG8_SCHED; PG8_LDA(At, 0, 0); PG8_STAGE(PG8_SA(1, 1), a1 + hA, voffA);
            PG8_WAIT_V(8); PG8_WAIT_L(0); PG8_BAR; PG8_MMA(0, 0, At, B0); PG8_MMA(0, 1, At, B1); PG8_BAR; PG8_SCHED;
            PG8_LDA(At, 0, 1); PG8_STAGE(PG8_SB(0, 0), b2, voffB); PG8_STAGE(PG8_SB(0, 1), b2 + hB, voffB); PG8_STAGE(PG8_SA(0, 0), a2, voffA);
            PG8_WAIT_V(8); PG8_WAIT_L(0); PG8_BAR; PG8_MMA(1, 0, At, B0); PG8_MMA(1, 1, At, B1); PG8_BAR; PG8_SCHED;
            PG8_LDB(B0, 1, 0); PG8_LDB(B1, 1, 1); PG8_SCHED; PG8_LDA(At, 1, 0); PG8_STAGE(PG8_SA(0, 1), a2 + hA, voffA);
            PG8_WAIT_V(8); PG8_WAIT_L(0); PG8_BAR; PG8_MMA(0, 0, At, B0); PG8_MMA(0, 1, At, B1); PG8_BAR; PG8_SCHED;
            PG8_LDA(At, 1, 1); PG8_STAGE(PG8_SB(1, 0), b3, voffB); PG8_STAGE(PG8_SB(1, 1), b3 + hB, voffB); PG8_STAGE(PG8_SA(1, 0), a3, voffA);
            PG8_WAIT_V(8); PG8_WAIT_L(0); PG8_BAR; PG8_MMA(1, 0, At, B0); PG8_MMA(1, 1, At, B1); PG8_BAR; PG8_SCHED;
        }
        if constexpr (ALIGN_EPI) { if (wr == 0) PG8_BAR; }
        f32x4 rl[NPART / 4];
#pragma unroll
        for (int i = 0; i < NPART / 4; ++i) rl[i] = (f32x4){0.f, 0.f, 0.f, 0.f};
        if constexpr (Epi::ROWSCALE) { if (has_next && tid < 256) { const f32x4* p_ = (const f32x4*)(E.part + (size_t)(nxt.pm * 256 + tid) * NPART);
#pragma unroll
            for (int i = 0; i < NPART / 4; ++i) rl[i] = p_[i]; } }
        E(acc, cur, wr, wc, fr, fq, rtab + (ui & 1) * 256);
        if (!has_next) break;
        if constexpr (Epi::ROWSCALE) { if (tid < 256) { f32x4 s_ = rl[0];
#pragma unroll
            for (int i = 1; i < NPART / 4; ++i) s_ += rl[i];
            rtab[((ui + 1) & 1) * 256 + tid] = __builtin_amdgcn_rsqf(((s_.x + s_.y) + (s_.z + s_.w)) * (1.0f / DM) + RMS_EPS); } }
#pragma unroll
        for (int a = 0; a < 2; ++a)
#pragma unroll
            for (int b = 0; b < 2; ++b)
#pragma unroll
                for (int m = 0; m < 4; ++m)
#pragma unroll
                    for (int n = 0; n < 2; ++n) acc[a][b][m][n] = (f32x4){0.f, 0.f, 0.f, 0.f};
        cur = nxt; cA = nA; cB = nB; ++ui;
        if constexpr (ALIGN_EPI) { if (wr == 1) PG8_BAR; }
    }
    PG8_WAIT_V(0);
    if constexpr (!ALIGN_EPI) { if (wr == 0) PG8_BAR; }
    PG8_BAR;
#undef PG8_RTAB_FILL
#undef PG8_SA
#undef PG8_SB
#undef PG8_STAGE
#undef PG8_LDA
#undef PG8_LDB
#undef PG8_MMA
#undef PG8_WAIT_V
#undef PG8_WAIT_L
#undef PG8_BAR
#undef PG8_SCHED
}

struct EpiQKV {
    static constexpr bool ROWSCALE = true;
    bf16_t* QKV; const float* part; LAS float* ex  ; const LAS float* gtab  ;
    __device__ __forceinline__ void operator()(const f32x4 (&acc)[2][2][4][2], const Unit& u, int wr, int wc, int fr, int fq, const LAS float* rt) const {
        const int row0 = u.pm * BM + wr * 64 + fr;
        const bool qk = u.pn < 16;
        if (qk) {
#pragma unroll
            for (int ai = 0; ai < 2; ++ai)
#pragma unroll
                for (int m = 0; m < 4; ++m) { const int rl = ai * HALF + wr * 64 + m * 16 + fr; const float rs = rt[rl];
#pragma unroll
                    for (int bj = 0; bj < 2; ++bj) { const f32x4 v0 = acc[ai][bj][m][0] * rs, v1 = acc[ai][bj][m][1] * rs;
                        float s = (v0[0] * v0[0] + v0[1] * v0[1]) + (v0[2] * v0[2] + v0[3] * v0[3]) + (v1[0] * v1[0] + v1[1] * v1[1]) + (v1[2] * v1[2] + v1[3] * v1[3]);
                        s += __shfl_xor(s, 16); s += __shfl_xor(s, 32);
                        if (fq == 0) ex[(rl * 2 + bj) * 4 + wc] = s; } }
            asm volatile("s_waitcnt lgkmcnt(0)" ::: "memory"); __builtin_amdgcn_s_barrier(); asm volatile("" ::: "memory");
        }
        f32x4 g0 = (f32x4){1.f, 1.f, 1.f, 1.f}, g1 = g0;
        if (qk) { const LAS float* gp = gtab + (u.pn >= 8 ? 128 : 0) + wc * 32 + 8 * fq; g0 = *(const LAS f32x4*)gp; g1 = *(const LAS f32x4*)(gp + 4); }
#pragma unroll
        for (int ai = 0; ai < 2; ++ai)
#pragma unroll
            for (int m = 0; m < 4; ++m) { const int rl = ai * HALF + wr * 64 + m * 16 + fr; const int row = row0 + ai * HALF + m * 16; const float rs = rt[rl];
#pragma unroll
                for (int bj = 0; bj < 2; ++bj) { float sc = rs;
                    if (qk) { const f32x4 p = *(const LAS f32x4*)(ex + (rl * 2 + bj) * 4); sc = rs * __builtin_amdgcn_rsqf(((p[0] + p[1]) + (p[2] + p[3])) * (1.0f / HD) + RMS_EPS); }
                    const f32x4 v0 = acc[ai][bj][m][0] * sc * g0, v1 = acc[ai][bj][m][1] * sc * g1;
                    u32x4 w; w.x = cvt_pk_bf16(v0[0], v0[1]); w.y = cvt_pk_bf16(v0[2], v0[3]); w.z = cvt_pk_bf16(v1[0], v1[1]); w.w = cvt_pk_bf16(v1[2], v1[3]);
                    *(u32x4*)(QKV + ((size_t)(2 * u.pn + bj) * S + row) * HD + wc * 32 + 8 * fq) = w; } }
    }
};
struct EpiGateUp {
    static constexpr bool ROWSCALE = true;
    bf16_t* H; const float* part;
    __device__ __forceinline__ void operator()(const f32x4 (&acc)[2][2][4][2], const Unit& u, int wr, int wc, int fr, int fq, const LAS float* rt) const {
        const int row0 = u.pm * BM + wr * 64 + fr;
#pragma unroll
        for (int ai = 0; ai < 2; ++ai)
#pragma unroll
            for (int m = 0; m < 4; ++m) { const int row = row0 + ai * HALF + m * 16; const float rs = rt[ai * HALF + wr * 64 + m * 16 + fr];
                const f32x4 g0 = acc[ai][0][m][0] * rs, g1 = acc[ai][0][m][1] * rs, u0 = acc[ai][1][m][0] * rs, u1 = acc[ai][1][m][1] * rs;
                f32x4 e0 = g0 * (-LOG2E), e1 = g1 * (-LOG2E);
#pragma unroll
                for (int i = 0; i < 4; ++i) { e0[i] = __builtin_amdgcn_exp2f(e0[i]); e1[i] = __builtin_amdgcn_exp2f(e1[i]); }
                e0 += 1.0f; e1 += 1.0f;
#pragma unroll
                for (int i = 0; i < 4; ++i) { e0[i] = __builtin_amdgcn_rcpf(e0[i]); e1[i] = __builtin_amdgcn_rcpf(e1[i]); }
                const f32x4 o0 = g0 * e0 * u0, o1 = g1 * e1 * u1;
                u32x4 w; w.x = cvtpk_s(o0[0], o0[1]); w.y = cvtpk_s(o0[2], o0[3]); w.z = cvtpk_s(o1[0], o1[1]); w.w = cvtpk_s(o1[2], o1[3]);
                *(u32x4*)(H + (size_t)row * FF + u.pn * HALF + wc * 32 + 8 * fq) = w; }
    }
};
template <bool HB  >
struct EpiResid {
    static constexpr bool ROWSCALE = false;
    const float* Xs; float* X; bf16_t* XB; float* part; const float* bias; const float* scale; bool feeds;
    __device__ __forceinline__ void operator()(const f32x4 (&acc)[2][2][4][2], const Unit& u, int wr, int wc, int fr, int fq, const LAS float*) const {
        const int row0 = u.pm * BM + wr * 64 + fr, col0 = u.pn * BM + wc * 32 + 8 * fq;
        f32x4 bv[2][2], sv[2][2];
#pragma unroll
        for (int bj = 0; bj < 2; ++bj)
#pragma unroll
            for (int n = 0; n < 2; ++n) { bv[bj][n] = HB ? *(const f32x4*)(bias + col0 + bj * HALF + 4 * n) : (f32x4){0.f, 0.f, 0.f, 0.f};
                                           sv[bj][n] = HB ? *(const f32x4*)(scale + col0 + bj * HALF + 4 * n) : (f32x4){1.f, 1.f, 1.f, 1.f}; }
        constexpr int NB = HB ? 4 : 2, MB = 4 / (NB / 2);
#pragma unroll
        for (int am = 0; am < NB; ++am) { const int ai = am / (NB / 2), m0 = (am % (NB / 2)) * MB;
            f32x4 xo[4][2][2];
#pragma unroll
            for (int m = m0; m < m0 + MB; ++m) { const float* xr = Xs + (size_t)(row0 + ai * HALF + m * 16) * DM + col0;
#pragma unroll
                for (int bj = 0; bj < 2; ++bj) { xo[m][bj][0] = *(const f32x4*)(xr + bj * HALF); xo[m][bj][1] = *(const f32x4*)(xr + bj * HALF + 4); } }
#pragma unroll
            for (int m = m0; m < m0 + MB; ++m) { const int row = row0 + ai * HALF + m * 16; float ss = 0.f;
                float* xr = X + (size_t)row * DM + col0; bf16_t* xb = XB + (size_t)row * ALD + col0;
#pragma unroll
                for (int bj = 0; bj < 2; ++bj) { f32x4 x0 = xo[m][bj][0], x1 = xo[m][bj][1];
                    if (HB) { x0 += (acc[ai][bj][m][0] + bv[bj][0]) * sv[bj][0]; x1 += (acc[ai][bj][m][1] + bv[bj][1]) * sv[bj][1]; } else { x0 += acc[ai][bj][m][0]; x1 += acc[ai][bj][m][1]; }
                    *(f32x4*)(xr + bj * HALF) = x0; *(f32x4*)(xr + bj * HALF + 4) = x1;
                    ss += (x0[0] * x0[0] + x0[1] * x0[1]) + (x0[2] * x0[2] + x0[3] * x0[3]) + (x1[0] * x1[0] + x1[1] * x1[1]) + (x1[2] * x1[2] + x1[3] * x1[3]);
                    u32x4 w; w.x = cvt_pk_bf16(x0[0], x0[1]); w.y = cvt_pk_bf16(x0[2], x0[3]); w.z = cvt_pk_bf16(x1[0], x1[1]); w.w = cvt_pk_bf16(x1[2], x1[3]);
                    if (feeds) *(u32x4*)(xb + bj * HALF) = w; }
                ss += __shfl_xor(ss, 16); ss += __shfl_xor(ss, 32);
                if (fq == 0 && feeds) part[(size_t)row * NPART + u.pn * 4 + wc] = ss; }
        }
    }
};
}

namespace att {
constexpr int D = 128, NW = 8, QBLK = 32, KVBLK = 64, QB = NW * QBLK;
constexpr int SHM_V = KVBLK * D * 2, SHM_K = KVBLK * D * 2;
constexpr int OFF_WS = 2 * SHM_V + 2 * SHM_K, OFF_CB = OFF_WS + NW * 64 * 4, OFF_Q = OFF_CB + 2 * 64 * 4, ATT_LDS = OFF_Q + NW * 8192;
static_assert(ATT_LDS <= LDS_BYTES, "attention LDS");
typedef const volatile LAS bf16x8* qlds_t;
constexpr int OSTR = ALD;
constexpr float THR2 = 64.0f;
#define KSWZ(row, colB) ((row) * 256 + ((colB) ^ (((row) & 7) << 4)))
#define SBAR() __builtin_amdgcn_sched_barrier(0)
__device__ __forceinline__ int v_st(int k, int c) { const int kk = (k & ~0xC) | ((k & 4) << 1) | ((k & 8) >> 1); return ((kk >> 3) * 4 + (c >> 5)) * 512 + ((kk & 7) * 32 + (c & 31)) * 2; }
__device__ __forceinline__ int v_rd_base(int lane) { return ((lane & 3) << 3) | (((lane >> 2) & 3) << 6) | (((lane >> 4) & 1) << 5) | (((lane >> 5) & 1) << 8); }
constexpr int v_rd_off(int d0, int ks, int half) { return d0 * 512 + ks * 4096 + half * 2048; }
__device__ __forceinline__ int crow(int r, int hi) { return (r & 3) + 8 * (r >> 2) + 4 * hi; }
__device__ __forceinline__ bf16x8 load8(const bf16_t* p) { return *reinterpret_cast<const bf16x8*>(p); }
__device__ __forceinline__ void mask_tile(f32x16& p0, f32x16& p1, int dq, unsigned W) {
    const float NEG = -__builtin_inff();
#pragma unroll
    for (int r = 0; r < 16; ++r) {
        const int c = (r & 3) + 8 * (r >> 2);
        if ((unsigned)(dq - c) >= W) p0[r] = NEG;
        if ((unsigned)(dq - c - 32) >= W) p1[r] = NEG;
    }
}
__device__ __forceinline__ void partialSM(f32x16& p0, f32x16& p1, float& m_reg, float& mn, float& alpha) {
    float pmax = p0[0];
#pragma unroll
    for (int r = 1; r < 16; ++r) pmax = fmaxf(pmax, p0[r]);
#pragma unroll
    for (int r = 0; r < 16; ++r) pmax = fmaxf(pmax, p1[r]);
    { auto rr = __builtin_amdgcn_permlane32_swap(__float_as_uint(pmax), __float_as_uint(pmax), false, false);
      pmax = fmaxf(__uint_as_float(rr[0]), __uint_as_float(rr[1])); }
    if (__builtin_expect(__all((pmax - m_reg) <= THR2), 1)) { mn = m_reg; alpha = 1.f; }
    else { mn = fmaxf(m_reg, pmax); alpha = __builtin_amdgcn_exp2f(m_reg - mn); m_reg = mn; }
#pragma unroll
    for (int r = 0; r < 16; ++r) { p0[r] -= mn; p1[r] -= mn; }
#pragma unroll
    for (int r = 0; r < 16; ++r) p0[r] = __builtin_amdgcn_exp2f(p0[r]);
}
__device__ __forceinline__ void finishSM(f32x16& p0, f32x16& p1, float alpha, float& l_reg, bf16x8& pa0, bf16x8& pa1, bf16x8& pa2, bf16x8& pa3) {
#pragma unroll
    for (int r = 0; r < 16; ++r) p1[r] = __builtin_amdgcn_exp2f(p1[r]);
    float ps = 0;
#pragma unroll
    for (int r = 0; r < 16; ++r) ps += p0[r];
#pragma unroll
    for (int r = 0; r < 16; ++r) ps += p1[r];
    { auto rr = __builtin_amdgcn_permlane32_swap(__float_as_uint(ps), __float_as_uint(ps), false, false);
      ps = __uint_as_float(rr[0]) + __uint_as_float(rr[1]); }
    l_reg = l_reg * alpha + ps;
#define PK4(P, B_, OUT) do { unsigned a0 = cvt_pk_bf16(P[B_+0], P[B_+1]), a1 = cvt_pk_bf16(P[B_+2], P[B_+3]);                          \
        unsigned b0 = cvt_pk_bf16(P[B_+4], P[B_+5]), b1 = cvt_pk_bf16(P[B_+6], P[B_+7]);                                             \
        auto r0 = __builtin_amdgcn_permlane32_swap(a0, b0, false, false); auto r1 = __builtin_amdgcn_permlane32_swap(a1, b1, false, false); \
        u32x4 w = {r0[0], r1[0], r0[1], r1[1]}; OUT = *reinterpret_cast<bf16x8*>(&w); } while (0)
    PK4(p0, 0, pa0); PK4(p0, 8, pa1); PK4(p1, 0, pa2); PK4(p1, 8, pa3);
#undef PK4
}
template <int KB>
__device__ __forceinline__ void qkt(f32x16& p0, f32x16& p1, const char* K_lds, const float* cb_l, int r32, int hi, qlds_t qL) {
    { const float* cbt = cb_l + KB * 64 + 4 * hi;
#pragma unroll
      for (int g4 = 0; g4 < 4; ++g4) { const f32x4 b0 = *(const f32x4*)(cbt + 8 * g4), b1 = *(const f32x4*)(cbt + 32 + 8 * g4);
#pragma unroll
          for (int i = 0; i < 4; ++i) { p0[4 * g4 + i] = b0[i]; p1[4 * g4 + i] = b1[i]; } } }
    const char* kb[4];
#pragma unroll
    for (int dd = 0; dd < 4; ++dd) kb[dd] = K_lds + KB * SHM_K + KSWZ(r32, (dd * 16 + hi * 8) * 2);
#pragma unroll
    for (int d0 = 0; d0 < 8; ++d0) { const char* a = kb[d0 & 3] + (d0 >> 2) * 128;
        bf16x8 b0 = *reinterpret_cast<const bf16x8*>(a);
        bf16x8 b1 = *reinterpret_cast<const bf16x8*>(a + 32 * 256);
        const bf16x8 q = qL[d0 * 64];
        p0 = __builtin_amdgcn_mfma_f32_32x32x16_bf16(b0, q, p0, 0, 0, 0);
        p1 = __builtin_amdgcn_mfma_f32_32x32x16_bf16(b1, q, p1, 0, 0, 0); }
}
template <int VB>
__device__ __forceinline__ void pv_tile(f32x16* o, int vb0, bf16x8 pa0, bf16x8 pa1, bf16x8 pa2, bf16x8 pa3) {
#define TRRD(dst, off) asm volatile("ds_read_b64_tr_b16 %0, %1 offset:%2" : "=&v"(dst) : "v"(vb0), "i"(off) : "memory")
#define PV_D0(d0) do { s16x4 l0, l1, l2, l3, h0, h1, h2, h3; constexpr int b_ = VB * SHM_V + v_rd_off(d0, 0, 0); \
        TRRD(l0, b_); TRRD(h0, b_ + 2048); TRRD(l1, b_ + 4096); TRRD(h1, b_ + 6144); TRRD(l2, b_ + 8192); TRRD(h2, b_ + 10240); TRRD(l3, b_ + 12288); TRRD(h3, b_ + 14336); \
        asm volatile("s_waitcnt lgkmcnt(0)" ::: "memory"); SBAR();   \
        o[d0] = __builtin_amdgcn_mfma_f32_32x32x16_bf16(pa0, (bf16x8){l0[0], l0[1], l0[2], l0[3], h0[0], h0[1], h0[2], h0[3]}, o[d0], 0, 0, 0);   \
        o[d0] = __builtin_amdgcn_mfma_f32_32x32x16_bf16(pa1, (bf16x8){l1[0], l1[1], l1[2], l1[3], h1[0], h1[1], h1[2], h1[3]}, o[d0], 0, 0, 0);   \
        o[d0] = __builtin_amdgcn_mfma_f32_32x32x16_bf16(pa2, (bf16x8){l2[0], l2[1], l2[2], l2[3], h2[0], h2[1], h2[2], h2[3]}, o[d0], 0, 0, 0);   \
        o[d0] = __builtin_amdgcn_mfma_f32_32x32x16_bf16(pa3, (bf16x8){l3[0], l3[1], l3[2], l3[3], h3[0], h3[1], h3[2], h3[3]}, o[d0], 0, 0, 0); } while (0)
    PV_D0(0); PV_D0(1); PV_D0(2); PV_D0(3);
#undef PV_D0
#undef TRRD
}
struct BlockRef { const bf16_t* Q; const bf16_t* K; const bf16_t* V; const float* CB; bf16_t* O; int P0; int jlo; };
struct Seam { bf16x8 qr[8]; bf16x8 st_v0, st_v1, st_k0, st_k1; float st_c; };
__device__ __forceinline__ int swa_jlo(int P0, int W) { const int lowk = P0 - W + 1; return lowk > 0 ? lowk / KVBLK : 0; }
#define ROW(p, k0, rr) ((p) + (size_t)((k0) + (rr)) * D + sc)
#define VMW() asm volatile("s_waitcnt vmcnt(0)" ::: "memory")
#define VMWN(n) asm volatile("s_waitcnt vmcnt(%0)" :: "i"(n) : "memory")
#define SLOAD_H(Kp, Vp, Cp, k0) do { const char* vb_ = (const char*)(Vp) + (size_t)(k0) * (D * 2); const char* kb_ = (const char*)(Kp) + (size_t)(k0) * (D * 2);     \
                         S.st_v0 = *(const bf16x8*)(vb_ + loff); S.st_v1 = *(const bf16x8*)(vb_ + 32 * D * 2 + loff);              \
                         S.st_k0 = *(const bf16x8*)(kb_ + loff); S.st_k1 = *(const bf16x8*)(kb_ + 32 * D * 2 + loff); S.st_c = *(const float*)((const char*)((Cp) + (k0)) + lane4); } while (0)
#define SWRITE_HK(bf) do { *(bf16x8*)(K_lds + (bf) * SHM_K + kws) = S.st_k0; *(bf16x8*)(K_lds + (bf) * SHM_K + kws + 32 * 256) = S.st_k1; cb_l[(bf) * 64 + lane] = S.st_c; } while (0)
#define SWRITE_HV(bf) do { *(bf16x8*)(V_lds + (bf) * SHM_V + vst0) = S.st_v0; *(bf16x8*)(V_lds + (bf) * SHM_V + vst1) = S.st_v1; } while (0)
#define SWRITE_H(bf) do { SWRITE_HV(bf); SWRITE_HK(bf); } while (0)
__device__ __forceinline__ void causal_prime(const BlockRef& cur, int W, char* lds, Seam& S) {
    int tid = threadIdx.x; asm volatile("" : "+v"(tid));
    const int wid = __builtin_amdgcn_readfirstlane(tid >> 6), lane = tid & 63, r32 = lane & 31, hi = lane >> 5;
    const int sr = tid >> 4, sc = (tid & 15) * 8, kws = KSWZ(sr, sc * 2); char* K_lds = lds + 2 * SHM_V; float* cb_l = (float*)(lds + OFF_CB);
    const unsigned loff = (unsigned)(sr * D + sc) * 2u, lane4 = (unsigned)lane * 4u;
    const int kb0 = cur.jlo * KVBLK;
#pragma unroll
    for (int d0 = 0; d0 < 8; ++d0) S.qr[d0] = load8(cur.Q + (size_t)(wid * QBLK + r32) * D + d0 * 16 + hi * 8);
    SLOAD_H(cur.K, cur.V, cur.CB, kb0); VMW(); SWRITE_HK(0);
    __syncthreads();
}
__device__ __forceinline__ void causal_block(const BlockRef& cur, const BlockRef& nxt, int skv, int W, char* lds, Seam& S) {
    int tid = threadIdx.x; asm volatile("" : "+v"(tid));
    const int wid = __builtin_amdgcn_readfirstlane(tid >> 6), lane = tid & 63, r32 = lane & 31, hi = lane >> 5;
    const int j_lo = cur.jlo;
    int j_hi = (cur.P0 + QB - 1) / KVBLK + 1; if (j_hi > skv / KVBLK) j_hi = skv / KVBLK;
    const int NT = j_hi - j_lo;
    const int kbn = nxt.jlo * KVBLK;
    const int qlo = cur.P0 + wid * QBLK, qm = qlo + r32 - 4 * hi;
    char* V_lds = lds; char* K_lds = lds + 2 * SHM_V; float* cb_l = (float*)(lds + OFF_CB);
    float* ws = (float*)(lds + OFF_WS) + wid * 64; float* li_l = ws, * al_l = ws + 32;
    float m_reg = -1e30f, l_reg = 0; f32x16 o[4] = {};
    const int sr = tid >> 4, sc = (tid & 15) * 8, vst0 = v_st(sr, sc), vst1 = v_st(32 + sr, sc), kws = KSWZ(sr, sc * 2);
    const int vb0 = (int)(uintptr_t)V_lds + v_rd_base(lane);
    const unsigned loff = (unsigned)(sr * D + sc) * 2u, lane4 = (unsigned)lane * 4u;
    const bf16_t* Kh = cur.K; const bf16_t* Vh = cur.V; const float* Ch = cur.CB;
#define RESC(a) do { if (__any((a) < 1.f)) { if (hi == 0) al_l[r32] = (a); asm volatile("s_waitcnt lgkmcnt(0)" ::: "memory");              \
                     for (int d_ = 0; d_ < 4; ++d_) for (int r = 0; r < 16; ++r) o[d_][r] *= al_l[crow(r, hi)]; } } while (0)
#define KBASE(t) ((j_lo + (t)) * KVBLK)
#define MASKT(P0_, P1_, t) do { const int kb_ = KBASE(t); if (kb_ + KVBLK - 1 > qlo || kb_ <= qlo + QBLK - 1 - W) mask_tile(P0_, P1_, qm - kb_, (unsigned)W); } while (0)
    constexpr int NQL = 8;
#define SEAM_K0() do { VMWN(NQL); SWRITE_HK(0); SBAR(); } while (0)
    f32x16 pA0, pA1, pB0, pB1; float mnA, mnB, alA, alB; bf16x8 pa0, pa1, pa2, pa3;
    LAS bf16x8* qW = (LAS bf16x8*)((LAS unsigned char*)0 + OFF_Q + wid * 8192) + lane;
#pragma unroll
    for (int d0 = 0; d0 < 8; ++d0) qW[d0 * 64] = S.qr[d0];
    const qlds_t qL = (qlds_t)qW;
    SWRITE_HV(0); SBAR();
    if (NT > 1) { SLOAD_H(Kh, Vh, Ch, KBASE(1)); }
    SBAR(); qkt<0>(pA0, pA1, K_lds, cb_l, r32, hi, qL);
    MASKT(pA0, pA1, 0); partialSM(pA0, pA1, m_reg, mnA, alA);
    if (NT > 1) { VMW(); SWRITE_H(1); }
    __syncthreads();
#define HALF_STEP(PX0, PX1, mnX, alX, PY0, PY1, alY, t, KB, VB, SB) do {                                                      \
        SBAR(); qkt<KB>(PX0, PX1, K_lds, cb_l, r32, hi, qL);                                             \
        finishSM(PY0, PY1, alY, l_reg, pa0, pa1, pa2, pa3); SBAR();                                                           \
        if ((t) + 1 < NT) { SLOAD_H(Kh, Vh, Ch, KBASE((t) + 1)); SBAR(); }                                               \
        pv_tile<VB>(o, vb0, pa0, pa1, pa2, pa3); MASKT(PX0, PX1, (t)); partialSM(PX0, PX1, m_reg, mnX, alX);                                        \
        __syncthreads();                                                                                                      \
        if ((t) + 1 < NT) { VMW(); SWRITE_H(SB); }                                                                          \
        RESC(alX); __syncthreads(); } while (0)
    for (int t = 1; t + 1 < NT; t += 2) {
        HALF_STEP(pB0, pB1, mnB, alB, pA0, pA1, alA, t, 1, 0, 0);
        HALF_STEP(pA0, pA1, mnA, alA, pB0, pB1, alB, t + 1, 0, 1, 1);
    }
    const bool even = (NT & 1) == 0;
    if (even) { SBAR(); qkt<1>(pB0, pB1, K_lds, cb_l, r32, hi, qL); SBAR(); }
    SLOAD_H(nxt.K, nxt.V, nxt.CB, kbn); SBAR();
#pragma unroll
    for (int d0 = 0; d0 < 8; ++d0) S.qr[d0] = load8(nxt.Q + (size_t)(wid * QBLK + r32) * D + d0 * 16 + hi * 8);
    SBAR();
    finishSM(pA0, pA1, alA, l_reg, pa0, pa1, pa2, pa3); SBAR();
    pv_tile<0>(o, vb0, pa0, pa1, pa2, pa3);
    if (even) { MASKT(pB0, pB1, NT - 1); partialSM(pB0, pB1, m_reg, mnB, alB); __syncthreads(); RESC(alB);
        finishSM(pB0, pB1, alB, l_reg, pa0, pa1, pa2, pa3); SBAR(); pv_tile<1>(o, vb0, pa0, pa1, pa2, pa3); }
    SBAR(); SEAM_K0();
    if (hi == 0) li_l[r32] = l_reg; asm volatile("s_waitcnt lgkmcnt(0)" ::: "memory");
    float rli[16];
#pragma unroll
    for (int r = 0; r < 16; ++r) rli[r] = __builtin_amdgcn_rcpf(li_l[crow(r, hi)]);
    bf16_t* Ow = cur.O + (size_t)(wid * QBLK) * OSTR;
#pragma unroll
    for (int r = 0; r < 16; ++r) { const int orow = crow(r, hi);
#pragma unroll
        for (int d0 = 0; d0 < 4; ++d0) { const float v = o[d0][r] * rli[r];
            const float vn = __shfl_xor(v, 1);
            if ((r32 & 1) == 0) *(unsigned*)(Ow + (size_t)orow * OSTR + d0 * 32 + r32) = cvt_pk_bf16(v, vn); } }
    __syncthreads();
#undef RESC
#undef KBASE
#undef MASKT
#undef SEAM_K0
#undef HALF_STEP
}
#undef ROW
#undef VMW
#undef VMWN
#undef SLOAD_H
#undef SWRITE_HK
#undef SWRITE_HV
#undef SWRITE_H
#undef SBAR
}

#ifndef REP_PRO
#define REP_PRO 1
#endif
#ifndef REP_GU
#define REP_GU 1
#endif
#ifndef REP_Y
#define REP_Y 1
#endif
#ifndef REP_FG
#define REP_FG 1
#endif
#ifndef REP_ATT
#define REP_ATT 1
#endif
#ifndef PH_MASK
#define PH_MASK 0xFFFF
#endif
#define PH(k) (((PH_MASK) >> (k)) & 1)
struct Args { const float* in[13]; float* out; unsigned char* ws; };


#define XB_TMO      128
#define XB_XCNT(j)  (256  + 64 * (j))
#define XB_XSUB(j)  (1280 + 64 * (j))
#define XB_XGEN(j)  (2304 + 64 * (j))
#define XB_TOP      3328
#define XB_TOPGEN   3392
#define XCD_BAR_WORDS 3456
#define XB_SPIN_CAP (1u << 22)
__device__ __forceinline__ unsigned xb_ld(unsigned* p)              { return __hip_atomic_load(p, __ATOMIC_RELAXED, __HIP_MEMORY_SCOPE_AGENT); }
__device__ __forceinline__ unsigned xb_add(unsigned* p, unsigned v) { return __hip_atomic_fetch_add(p, v, __ATOMIC_RELAXED, __HIP_MEMORY_SCOPE_AGENT); }
__device__ __forceinline__ unsigned xb_xcc_id() { return (unsigned)__builtin_amdgcn_s_getreg((3 << 11) | 20) & 0xFu; }
#define XB_SPIN(cond, bar) do { unsigned _sp = 0; while (cond) { __builtin_amdgcn_s_sleep(1); \
    if ((++_sp & 255u) == 0u) { if (xb_ld(&(bar)[XB_TMO])) break; if (_sp > XB_SPIN_CAP) { atomicAdd(&(bar)[XB_TMO], 1u); break; } } } } while (0)
struct XcdBarrier { unsigned* bar; unsigned x; volatile LAS unsigned* st; };
__device__ __forceinline__ XcdBarrier xcd_barrier_post(unsigned* bar, volatile LAS unsigned* st) {
    XcdBarrier b; b.bar = bar; b.x = xb_xcc_id(); b.st = st;
    if (threadIdx.x == 0) (void)xb_add(&bar[XB_XCNT(b.x)], 1u);
    return b;
}
__device__ __forceinline__ void xcd_barrier_complete(unsigned* bar, unsigned x, unsigned& nloc, unsigned& nx) {
    const unsigned G = gridDim.x * gridDim.y * gridDim.z;
    unsigned sum, cnt, mine, sp = 0u;
    for (;;) {
        sum = 0u; cnt = 0u; mine = 0u;
#pragma unroll
        for (unsigned j = 0; j < 16; ++j) { const unsigned c = xb_ld(&bar[XB_XCNT(j)]); sum += c; cnt += (c > 0u) ? 1u : 0u; mine = (j == x) ? c : mine; }
        if (sum == G) break;
        __builtin_amdgcn_s_sleep(1);
        if ((++sp & 255u) == 0u) { if (xb_ld(&bar[XB_TMO])) break; if (sp > XB_SPIN_CAP) { atomicAdd(&bar[XB_TMO], 1u); break; } }
    }
    nloc = mine > 0u ? mine : 1u; nx = cnt > 0u ? cnt : 1u;
}
__device__ __forceinline__ void xcd_barrier(const XcdBarrier& b) {
    asm volatile("s_waitcnt vmcnt(0)" ::: "memory");
    __syncthreads();
    if (threadIdx.x == 0) {
        unsigned* bar = b.bar;
        __builtin_amdgcn_s_waitcnt(0);
        unsigned nloc = b.st[0], nx = b.st[1];
        if (nloc == 0u) { xcd_barrier_complete(bar, b.x, nloc, nx); b.st[0] = nloc; b.st[1] = nx; }
        const unsigned old = xb_add(&bar[XB_XSUB(b.x)], 1u);
        const unsigned gen = old / nloc;
        if (old + 1u == (gen + 1u) * nloc) {
            __builtin_amdgcn_fence(__ATOMIC_RELEASE, "agent");
            asm volatile("s_waitcnt vmcnt(0)" ::: "memory");
            const unsigned og = xb_add(&bar[XB_TOP], 1u);
            const unsigned tg = og / nx;
            if (og + 1u == (tg + 1u) * nx) xb_add(&bar[XB_TOPGEN], 1u);
            else XB_SPIN(xb_ld(&bar[XB_TOPGEN]) == tg, bar);
            __builtin_amdgcn_fence(__ATOMIC_ACQUIRE, "agent");
            xb_add(&bar[XB_XGEN(b.x)], 1u);
            asm volatile("s_waitcnt vmcnt(0)" ::: "memory");
        } else {
            XB_SPIN(xb_ld(&bar[XB_XGEN(b.x)]) == gen, bar);
            __builtin_amdgcn_fence(__ATOMIC_ACQUIRE, "agent");
            asm volatile("s_waitcnt vmcnt(0)" ::: "memory");
        }
    }
    __syncthreads();
}

__device__ __forceinline__ void cg_sync() { cg::this_grid().sync(); }

__device__ __forceinline__ void conv_item(const float* W, int ldw, int Nout, int mode, const float* gk, unsigned char* dst, int item, int lane, LAS unsigned char* wl  ) {
    const int nblk = Nout >> 8, k32 = item / nblk, nb0 = (item - k32 * nblk) * 256, nb = nb0 + lane * 4;
    int sc = nb; if (mode == 1) sc = ((nb >> 7) & 1) * FF + (nb >> 8) * 128 + (nb & 127);
    const float* src = W + (size_t)(k32 * 32) * ldw + sc;
    f32x4 v[32];
#pragma unroll
    for (int i = 0; i < 32; ++i) v[i] = __builtin_nontemporal_load((const f32x4*)(src + (size_t)i * ldw));
    if (gk) {
#pragma unroll
        for (int i = 0; i < 32; ++i) v[i] *= gk[k32 * 32 + i]; }
    LAS unsigned char* mine = wl + lane * 272;
#pragma unroll
    for (int j = 0; j < 4; ++j)
#pragma unroll
        for (int q = 0; q < 4; ++q) { u32x4 w;
            w.x = cvt_pk_bf16(v[8 * q + 0][j], v[8 * q + 1][j]); w.y = cvt_pk_bf16(v[8 * q + 2][j], v[8 * q + 3][j]);
            w.z = cvt_pk_bf16(v[8 * q + 4][j], v[8 * q + 5][j]); w.w = cvt_pk_bf16(v[8 * q + 6][j], v[8 * q + 7][j]);
            *(LAS u32x4*)(mine + (j * 4 + q) * 16) = w; }
    asm volatile("s_waitcnt lgkmcnt(0)" ::: "memory");
    unsigned char* d = dst + ((size_t)k32 * Nout + nb0) * 64 + lane * 16;
    const LAS unsigned char* rd = wl + (lane >> 4) * 272 + (lane & 15) * 16;
#pragma unroll
    for (int s = 0; s < 16; ++s) { const u32x4 w = *(const LAS u32x4*)(rd + s * 4 * 272); *(u32x4*)(d + s * 1024) = w; }
    asm volatile("s_waitcnt lgkmcnt(0)" ::: "memory");
}

__global__ void __launch_bounds__(NTHREADS, 2) fwd_megakernel(Args args) {
    extern __shared__ __attribute__((aligned(16))) unsigned char lds_raw[];
    LAS unsigned char* lds = (LAS unsigned char*)lds_raw;
#define PHASE_IDS() int tid = threadIdx.x; asm volatile("" : "+v"(tid)); const int lane = tid & 63, wid = __builtin_amdgcn_readfirstlane(tid >> 6), gw = vcu * 8 + wid; (void)lane; (void)gw
    const int G = gridDim.x, bx = blockIdx.x;
    const int vcu = (G % 8 == 0) ? (bx % 8) * (G / 8) + bx / 8 : bx;
    const int NGW = G * 8;
    volatile LAS unsigned* bst = (volatile LAS unsigned*)(lds + LDS_BYTES - 16);
    if (threadIdx.x < 2) bst[threadIdx.x] = 0u;
    __syncthreads();
    const XcdBarrier xbar = xcd_barrier_post((unsigned*)args.ws, bst);
#define grid_sync() xcd_barrier(xbar)
    unsigned char* ws = args.ws;
    const float* x_in = args.in[0]; const float* mix_g = args.in[1]; const float* ffn_g = args.in[2];
    const float* w_in = args.in[3]; const float* b_f = args.in[4]; const float* gq = args.in[5]; const float* gk = args.in[6];
    const float* w_out = args.in[7]; const float* pool_w = args.in[8]; const float* pool_b = args.in[9]; const float* pool_s = args.in[10];
    const float* w_gu = args.in[11]; const float* w_dn = args.in[12];
    float* X = args.out;
    float* part = (float*)(ws + WS_PART); float* logf_ = (float*)(ws + WS_LOGF); float* cb = (float*)(ws + WS_CB);
    int* jtab = (int*)(ws + WS_LOGF + 768 * 1024); float* wf_tab = (float*)(ws + WS_CB + 512 * 1024);
    bf16_t* XB = (bf16_t*)(ws + WS_XB); bf16_t* QKV = (bf16_t*)(ws + WS_QKV); bf16_t* OB = (bf16_t*)(ws + WS_O); bf16_t* HB = (bf16_t*)(ws + WS_H);

#define CONV_JOB(W_, ldw_, K_, Nout_, mode_, g_, dst_) do { const int n_ = ((K_) / 32) * ((Nout_) / 256); \
            for (; it < n_; it += nw_c) { const int gi_ = cbase + it; if (gi_ >= clo && gi_ < chi) conv_item(W_, ldw_, Nout_, mode_, g_, dst_, it, lane, lds + wid * 17408); } it -= n_; cbase += n_; } while (0)
#define CONV_LAYER(l_, it0_, nw_, lo_, hi_, mask_) do { const int lc = (l_), jc = lc >> 1, nw_c = (nw_), clo = (lo_), chi = (hi_), mk = (mask_); int it = (it0_), cbase = 0;     \
        if ((lc & 1) == 0) { \
            if (mk & 1) CONV_JOB(w_in + (size_t)jc * DM * WIN_LD, WIN_LD, DM, 3 * DM, 0, mix_g + (size_t)lc * DM, ws + WS_WIN + (size_t)jc * 24 * MiB); \
            if (mk & 8) CONV_JOB(w_out + (size_t)jc * DM * DM, DM, DM, DM, 0, (const float*)nullptr, ws + WS_WOUT + (size_t)jc * 8 * MiB); \
        } else if (mk & 1) { \
            for (int g4 = 0; g4 < 4; ++g4) \
                CONV_JOB(pool_w + ((size_t)jc * 4 + g4) * 512 * 512, 512, 512, 512, 0, (const float*)nullptr, ws + WS_WPOOL + (size_t)jc * 2 * MiB + (size_t)g4 * 512 * 512 * 2); \
        } \
        if (mk & 2) CONV_JOB(w_gu + (size_t)lc * DM * 2 * FF, 2 * FF, DM, 2 * FF, 1, ffn_g + (size_t)lc * DM, ws + WS_WGU + (size_t)lc * 44 * MiB); \
        if (mk & 4) CONV_JOB(w_dn + (size_t)lc * FF * DM, DM, FF, DM, 0, (const float*)nullptr, ws + WS_WDN + (size_t)lc * 22 * MiB); } while (0)
    for (int rep_ = 0; rep_ < REP_PRO; ++rep_) if constexpr (PH(0)) {
        PHASE_IDS();
        CONV_LAYER(0, gw, NGW, 0, 0x7fffffff, 3);
        for (int i = gw * 64 + lane; i < 2 * DM * 4; i += NGW * 64) { const int jf = i >> 13, d = (i >> 2) & (DM - 1), q = i & 3;
            const f32x4 w = *(const f32x4*)(w_in + (size_t)jf * DM * WIN_LD + (size_t)d * WIN_LD + 3 * DM + 4 * q); const float gd = mix_g[(size_t)(2 * jf) * DM + d];
#pragma unroll
            for (int k = 0; k < 4; ++k) wf_tab[((size_t)jf * NH + 4 * q + k) * DM + d] = w[k] * gd; }
        for (int row = gw; row < S; row += NGW) {
            const f32x4* xr = (const f32x4*)(x_in + (size_t)row * DM) + lane;
            u32x2* xb = (u32x2*)(XB + (size_t)row * ALD) + lane; float ss = 0.f;
#pragma unroll
            for (int j = 0; j < 8; ++j) { const f32x4 v = xr[64 * j]; ss += (v.x * v.x + v.y * v.y) + (v.z * v.z + v.w * v.w);
                u32x2 w; w.x = cvt_pk_bf16(v.x, v.y); w.y = cvt_pk_bf16(v.z, v.w); xb[64 * j] = w; }
            ss = wave_sum(ss);
            if (lane < NPART) part[(size_t)row * NPART + lane] = (lane == 0) ? ss : 0.f;
        }
    }
    cg_sync();

#pragma unroll 1
    for (int layer = 0; layer < NLAYER; ++layer) {
        const int j = layer >> 1;
        if ((layer & 1) == 0) {
            for (int rep_ = 0; rep_ < REP_FG; ++rep_) if constexpr (PH(1)) {
                PHASE_IDS();
                LAS float* wfl = (LAS float*)lds;
                { const f32x4* wsrc = (const f32x4*)(wf_tab + (size_t)j * NH * DM);
                  for (int idx = tid; idx < NH * DM / 4; idx += NTHREADS) ((LAS f32x4*)wfl)[idx] = wsrc[idx]; }
                __syncthreads();
                for (int grp = gw; grp < S / 4; grp += NGW) {
                    const int t0 = grp * 4;
                    float acc[64]; float ss[4] = {0.f, 0.f, 0.f, 0.f};
#pragma unroll
                    for (int i = 0; i < 64; ++i) acc[i] = 0.f;
#pragma unroll 2
                    for (int jj = 0; jj < 8; ++jj) {
                        f32x4 xv[4];
#pragma unroll
                        for (int r = 0; r < 4; ++r) { const u32x2 raw = *(const u32x2*)(XB + (size_t)(t0 + r) * ALD + 256 * jj + 4 * lane);
                            xv[r] = (f32x4){__uint_as_float(raw.x << 16), __uint_as_float(raw.x & 0xffff0000u), __uint_as_float(raw.y << 16), __uint_as_float(raw.y & 0xffff0000u)};
                            ss[r] += (xv[r].x * xv[r].x + xv[r].y * xv[r].y) + (xv[r].z * xv[r].z + xv[r].w * xv[r].w); }
#pragma unroll
                        for (int h = 0; h < 16; ++h) { const f32x4 w = *(const LAS f32x4*)(wfl + h * DM + 256 * jj + 4 * lane);
#pragma unroll
                            for (int r = 0; r < 4; ++r) acc[r * 16 + h] += (xv[r].x * w.x + xv[r].y * w.y) + (xv[r].z * w.z + xv[r].w * w.w); }
                    }
#pragma unroll
                    for (int s = 32, n = 64; s >= 1; s >>= 1, n >>= 1) {
#pragma unroll
                        for (int i = 0; i < n / 2; ++i) { const bool up = (lane & s) != 0; const float a = acc[i], b = acc[i + n / 2];
                            const float send = up ? a : b, keep = up ? b : a; acc[i] = keep + __shfl_xor(send, s); } }
#pragma unroll
                    for (int r = 0; r < 4; ++r) ss[r] = wave_sum(ss[r]);
                    const int r = lane >> 4, h = lane & 15;
                    const float sr = (r == 0) ? ss[0] : (r == 1) ? ss[1] : (r == 2) ? ss[2] : ss[3];
                    const float f = acc[0] * __builtin_amdgcn_rsqf(sr * (1.0f / DM) + RMS_EPS) + b_f[j * NH + h];
                    const float lf = fminf(f, 0.f) - log1pf(expf(-fabsf(f)));
                    logf_[(size_t)h * S + t0 + r] = lf;
                }
                __syncthreads();
            }
            if constexpr (PH(2)) {
                pg8::Gemm g{(const char*)XB, (const char*)(ws + WS_WIN + (size_t)j * 24 * MiB), ALD, 3 * DM, DM, S / 256, 3 * DM / 256, 31, 0x7fffffff, 0u, 0u};
                LAS float* gtab = (LAS float*)(lds + 131072 + 2048 + 8192);
                { PHASE_IDS(); if (tid < HD) { gtab[tid] = gq[j * HD + tid] * QSCALE; gtab[HD + tid] = gk[j * HD + tid]; } }
                pg8::EpiQKV E{QKV, part, (LAS float*)(lds + 131072 + 2048), gtab};
                pg8::gemm_phase<pg8::EpiQKV, true>(lds, g, G, bx, E);
            }
            grid_sync();
            if (PH(3) && bx >= NH) {
                PHASE_IDS();
                CONV_LAYER(layer, (bx - NH) * 8 + wid, (G - NH) * 8, 0, 0x7fffffff, 8);
                __syncthreads();
            }
            if (PH(3) && bx < NH) {
                PHASE_IDS();
                LAS float* wtot = (LAS float*)lds; LAS float* gmx = (LAS float*)(lds + 64); LAS float* cl = (LAS float*)(lds + 2048);
                const int h = bx; const f32x4* lf = (const f32x4*)(logf_ + (size_t)h * S + tid * 16);
                float v[16];
#pragma unroll
                for (int i = 0; i < 4; ++i) { const f32x4 q = lf[i]; v[4 * i] = q.x; v[4 * i + 1] = q.y; v[4 * i + 2] = q.z; v[4 * i + 3] = q.w; }
#pragma unroll
                for (int i = 1; i < 16; ++i) v[i] += v[i - 1];
                const float total = v[15]; float incl = total;
#pragma unroll
                for (int o = 1; o < 64; o <<= 1) { const float t = __shfl_up(incl, o); if (lane >= o) incl += t; }
                if (lane == 63) wtot[wid] = incl;
                __syncthreads();
                float base = incl - total;
                for (int w = 0; w < wid; ++w) base += wtot[w];
                f32x4* co = (f32x4*)(cb + (size_t)h * S + tid * 16);
#pragma unroll
                for (int i = 0; i < 4; ++i) co[i] = (f32x4){-(base + v[4 * i]) * LOG2E, -(base + v[4 * i + 1]) * LOG2E, -(base + v[4 * i + 2]) * LOG2E, -(base + v[4 * i + 3]) * LOG2E};
#pragma unroll
                for (int i = 0; i < 16; ++i) cl[tid * 16 + i] = base + v[i];
                if (tid < HD) { gmx[tid] = fabsf(gq[j * HD + tid]); gmx[HD + tid] = fabsf(gk[j * HD + tid]); }
                __syncthreads();
                if (tid < S / 256) { float a = 0.f, b = 0.f;
                    for (int i = 0; i < HD; ++i) { a = fmaxf(a, gmx[i]); b = fmaxf(b, gmx[HD + i]); }
                    const float T = 2.04f * (11.3137085f * a * b) + 25.66f;
                    const int P0 = tid * 256; const float target = cl[P0] + T; int lo = 0, hi = P0;
                    while (lo < hi) { const int mid = (lo + hi) >> 1; if (cl[mid] <= target) hi = mid; else lo = mid + 1; }
                    jtab[h * (S / 256) + tid] = lo >> 6; }
            }
            grid_sync();
            for (int rep_ = 0; rep_ < REP_ATT; ++rep_) if constexpr (PH(4)) {
                char* alds = (char*)lds_raw;
                const bf16_t* Qb = QKV; const bf16_t* Kb = QKV + (size_t)NH * S * HD; const bf16_t* Vb = QKV + (size_t)2 * NH * S * HD;
                constexpr int TOTAL = NH * (S / 256); const int W = S;
                volatile LAS unsigned* sched = (volatile LAS unsigned*)(lds + LDS_BYTES - 32);
                unsigned* ctr = (unsigned*)args.ws + 3584 + 64 * j + 16 * rep_;
                int L = vcu;
                if (L < TOTAL) {
#define AREF(r, L_) do { const int h_ = (L_) & 15, qb_ = 31 - ((L_) >> 4);     (r).Q = Qb + ((size_t)h_ * S + (size_t)qb_ * 256) * HD; (r).K = Kb + (size_t)h_ * S * HD; (r).V = Vb + (size_t)h_ * S * HD; \
                              (r).CB = cb + (size_t)h_ * S; (r).O = OB + (size_t)qb_ * 256 * ALD + h_ * HD; (r).P0 = qb_ * 256; (r).jlo = jtab[h_ * 32 + qb_]; } while (0)
                    att::BlockRef cur, nxt; AREF(cur, L);
                    if (threadIdx.x == 0) sched[0] = atomicAdd(ctr, 1u) + (unsigned)G;
                    __syncthreads();
                    int Ln = (int)sched[0];
                    att::Seam Sm;
                    att::causal_prime(cur, W, alds, Sm);
                    for (int slot = 1;; slot ^= 1) {
                        const bool last = Ln >= TOTAL;
                        if (last) nxt = cur; else AREF(nxt, Ln);
                        if (threadIdx.x == 0) sched[slot] = atomicAdd(ctr, 1u) + (unsigned)G;
                        att::causal_block(cur, nxt, S, W, alds, Sm);
                        if (last) break;
                        cur = nxt; Ln = (int)sched[slot];
                    }
#undef AREF
                }
            }
            grid_sync();
            if constexpr (PH(5)) {
                pg8::Gemm g{(const char*)OB, (const char*)(ws + WS_WOUT + (size_t)j * 8 * MiB), ALD, DM, DM, S / 256, DM / 256, 31, 0x7fffffff, 0u, 0u};
                pg8::EpiResid<false> E{layer == 0 ? x_in : X, X, XB, part, nullptr, nullptr, true};
                pg8::gemm_phase<pg8::EpiResid<false>, false>(lds, g, G, bx, E);
            }
            grid_sync();
        } else {
            for (int rep_ = 0; rep_ < REP_Y; ++rep_) if constexpr (PH(6)) {
                PHASE_IDS();
                LAS f32x4* tile = (LAS f32x4*)lds;
                LAS float* rsl = (LAS float*)(lds + 47 * 128 * 16);
                const float* gm = mix_g + (size_t)layer * DM;
                u32x4 xv[6]; f32x4 g8a = (f32x4){0.f, 0.f, 0.f, 0.f}, g8b = g8a; float rsv = 0.f;
#pragma unroll
                for (int i = 0; i < 6; ++i) xv[i] = (u32x4){0u, 0u, 0u, 0u};
#define Y_LOAD(u_) do { const int ch_ = (u_) >> 2, gr_ = (((u_) & 3) + ((u_) >> 8)) & 3, t0_ = ch_ * 32, c0_ = gr_ * 512; \
                    g8a = *(const f32x4*)(gm + c0_ + 8 * (tid & 63)); g8b = *(const f32x4*)(gm + c0_ + 8 * (tid & 63) + 4); \
                    if (tid < 47) { const int row_ = t0_ - 15 + tid; rsv = row_ >= 0 ? row_rstd(part, row_) : 0.f; } \
                    _Pragma("unroll") for (int i = 0; i < 6; ++i) { const int idx = tid + NTHREADS * i, r = idx >> 6, q = idx & 63; const int row_ = t0_ - 15 + r; \
                        xv[i] = (r < 47 && row_ >= 0) ? *(const u32x4*)(XB + (size_t)row_ * ALD + c0_ + 8 * q) : (u32x4){0u, 0u, 0u, 0u}; } } while (0)
                int u = vcu; if (u < 1024) Y_LOAD(u);
                while (u < 1024) {
                    const int chunk = u >> 2, grp = ((u & 3) + (u >> 8)) & 3, t0 = chunk * 32, c0 = grp * 512, w = 2 << grp;
                    if (tid < 47) rsl[tid] = rsv;
#pragma unroll
                    for (int i = 0; i < 6; ++i) { const int idx = tid + NTHREADS * i, r = idx >> 6, q = idx & 63;
                        if (r < 47) { const u32x4 b = xv[i];
                            tile[r * 128 + 2 * q] = (f32x4){__uint_as_float(b.x << 16), __uint_as_float(b.x & 0xffff0000u), __uint_as_float(b.y << 16), __uint_as_float(b.y & 0xffff0000u)} * g8a;
                            tile[r * 128 + 2 * q + 1] = (f32x4){__uint_as_float(b.z << 16), __uint_as_float(b.z & 0xffff0000u), __uint_as_float(b.w << 16), __uint_as_float(b.w & 0xffff0000u)} * g8b; } }
                    __syncthreads();
                    const int un = u + G; if (un < 1024) Y_LOAD(un);
                    const int cq = tid & 127, tb = tid >> 7;
#pragma unroll 1
                    for (int k = 0; k < 8; ++k) { const int tl = tb * 8 + k; f32x4 s = (f32x4){0.f, 0.f, 0.f, 0.f};
                        for (int i = 0; i < w; ++i) s += tile[(tl + 15 - i) * 128 + cq] * rsl[tl + 15 - i];
                        const int t = t0 + tl; const int cnt = (t + 1 < w) ? t + 1 : w;
                        const f32x4 y = s * (1.0f / (float)cnt) - tile[(tl + 15) * 128 + cq] * rsl[tl + 15];
                        u32x2 o; o.x = cvt_pk_bf16(y.x, y.y); o.y = cvt_pk_bf16(y.z, y.w);
                        *(u32x2*)(OB + (size_t)t * ALD + c0 + 4 * cq) = o; }
                    __syncthreads();
                    u = un;
                }
#undef Y_LOAD
            }
            grid_sync();
            if constexpr (PH(7)) {
                pg8::Gemm g{(const char*)OB, (const char*)(ws + WS_WPOOL + (size_t)j * 2 * MiB), ALD, 512, 512, S / 256, DM / 256, 1, 1, 1024u, 512u * 512u * 2u};
                pg8::EpiResid<true> E{X, X, XB, part, pool_b + (size_t)j * DM, pool_s + (size_t)j * DM, true};
                pg8::gemm_phase<pg8::EpiResid<true>, false>(lds, g, G, bx, E);
            }
            grid_sync();
        }
        for (int rep_ = 0; rep_ < REP_GU; ++rep_) if constexpr (PH(8)) {
            pg8::Gemm g{(const char*)XB, (const char*)(ws + WS_WGU + (size_t)layer * 44 * MiB), ALD, 2 * FF, DM, S / 256, 2 * FF / 256, 31, 0x7fffffff, 0u, 0u};
            pg8::EpiGateUp E{HB, part};
            pg8::gemm_phase<pg8::EpiGateUp, true>(lds, g, G, bx, E);
            {
                PHASE_IDS();
                const int rem = ((S / 256) * (2 * FF / 256)) % G, nidle = rem ? G - rem : G, idx = rem ? bx - rem : bx;
                if (idx >= 0) {
                    constexpr int L2_ITEMS = 1536 + 2816, L2_CUT = L2_ITEMS - 940;
                    if (layer + 1 < NLAYER) CONV_LAYER(layer + 1, idx * 8 + wid, nidle * 8, 0, (layer == 1 ? L2_CUT : 0x7fffffff), 3);
                    if (layer == 0) CONV_LAYER(2, idx * 8 + wid, nidle * 8, L2_CUT, 0x7fffffff, 3);
                    CONV_LAYER(layer, nidle * 8 - 1 - (idx * 8 + wid), nidle * 8, 0, 0x7fffffff, 4);
                }
                __syncthreads();
            }
        }
        grid_sync();
        if constexpr (PH(9)) {
            pg8::Gemm g{(const char*)HB, (const char*)(ws + WS_WDN + (size_t)layer * 22 * MiB), FF, DM, FF, S / 256, DM / 256, 31, 0x7fffffff, 0u, 0u};
            pg8::EpiResid<false> E{X, X, XB, part, nullptr, nullptr, layer + 1 < NLAYER};
            pg8::gemm_phase<pg8::EpiResid<false>, false>(lds, g, G, bx, E);
        }
        if (layer + 1 < NLAYER) grid_sync();
    }
}

extern "C" void kernel_launch(void* const* d_in, const int* in_sizes, int n_in, void* d_out, int out_size, void* d_ws, size_t ws_size, hipStream_t stream) {
    static int grid = 0;
    if (grid == 0) {
        if (n_in != 13 || out_size != S * DM || ws_size < WS_END) { fprintf(stderr, "kernel_launch: unexpected shapes (n_in %d out %d ws %zu)\n", n_in, out_size, ws_size); grid = -1; return; }
        int dev = 0, cus = 0, per_cu = 0;
        hipGetDevice(&dev); hipDeviceGetAttribute(&cus, hipDeviceAttributeMultiprocessorCount, dev);
        if (hipFuncSetAttribute((const void*)fwd_megakernel, hipFuncAttributeMaxDynamicSharedMemorySize, LDS_BYTES) != hipSuccess) { fprintf(stderr, "kernel_launch: hipFuncSetAttribute failed\n"); grid = -1; return; }
        if (hipOccupancyMaxActiveBlocksPerMultiprocessor(&per_cu, (const void*)fwd_megakernel, NTHREADS, LDS_BYTES) != hipSuccess || per_cu < 1) { fprintf(stderr, "kernel_launch: occupancy query says %d\n", per_cu); per_cu = 1; }
        (void)hipGetLastError();
        grid = cus * 1;
        fprintf(stderr, "kernel_launch: cus %d per_cu %d grid %d\n", cus, per_cu, grid);
    }
    if (grid < 0) return;
    if (hipMemsetAsync(d_ws, 0, 16384, stream) != hipSuccess) { fprintf(stderr, "kernel_launch: memset failed\n"); return; }
    Args a{};
    for (int i = 0; i < 13; ++i) a.in[i] = (const float*)d_in[i];
    a.out = (float*)d_out; a.ws = (unsigned char*)d_ws;
    void* kargs[] = {&a};
    hipError_t e = hipLaunchCooperativeKernel((const void*)fwd_megakernel, dim3(grid), dim3(NTHREADS), kargs, LDS_BYTES, stream);
    if (e != hipSuccess) fprintf(stderr, "cooperative launch failed: %s (grid %d)\n", hipGetErrorString(e), grid);
}
```

```cpp
#include <hip/hip_runtime.h>
#include <hip/hip_cooperative_groups.h>
#include <cstdio>
#include <cstdint>
namespace cg = cooperative_groups;

#define LAS __attribute__((address_space(3)))
typedef unsigned short bf16_t;
typedef short bf16x8 __attribute__((ext_vector_type(8)));
typedef short s16x4 __attribute__((ext_vector_type(4)));
typedef float f32x4 __attribute__((ext_vector_type(4)));
typedef float f32x16 __attribute__((ext_vector_type(16)));
typedef unsigned u32x4 __attribute__((ext_vector_type(4)));
typedef unsigned u32x2 __attribute__((ext_vector_type(2)));

constexpr int S = 8192, DM = 2048, NH = 16, HD = 128, FF = 5632, NLAYER = 4;
constexpr int WIN_LD = 3 * DM + NH;
constexpr float RMS_EPS = 1e-6f;
constexpr float LOG2E = 1.4426950408889634f;
constexpr float QSCALE = 0.08838834764831845f * 1.4426950408889634f;
constexpr int NPART = 32;

constexpr size_t MiB = 1u << 20;
constexpr size_t WS_PART = 1 * MiB;
constexpr size_t WS_LOGF = 2 * MiB;
constexpr size_t WS_CB = 3 * MiB;
constexpr size_t WS_XB = 588 * MiB;
constexpr size_t WS_QKV = 36 * MiB;
constexpr size_t WS_O = 624 * MiB;
constexpr size_t WS_H = 164 * MiB;
constexpr size_t WS_WIN = 256 * MiB;
constexpr size_t WS_WOUT = 304 * MiB;
constexpr size_t WS_WPOOL = 320 * MiB;
constexpr size_t WS_WGU = 324 * MiB;
constexpr size_t WS_WDN = 500 * MiB;
constexpr size_t WS_END = 660 * MiB;
constexpr int ALD = DM + 64;

constexpr int STAGE_BYTES = 131072;
constexpr int LDS_BYTES = 147456;
constexpr int NTHREADS = 512;

__device__ __forceinline__ unsigned cvt_pk_bf16(float lo, float hi) { unsigned r; asm volatile("v_cvt_pk_bf16_f32 %0, %1, %2" : "=v"(r) : "v"(lo), "v"(hi)); return r; }
typedef float f32x2_t __attribute__((ext_vector_type(2))); typedef __bf16 bf16x2_t __attribute__((ext_vector_type(2)));
__device__ __forceinline__ unsigned cvtpk_s(float lo, float hi) { f32x2_t v = {lo, hi}; bf16x2_t b = __builtin_convertvector(v, bf16x2_t); return __builtin_bit_cast(unsigned, b); }
__device__ __forceinline__ float bf2f(unsigned short h) { return __uint_as_float((unsigned)h << 16); }
__device__ __forceinline__ float wave_sum(float v) {
#pragma unroll
    for (int o = 1; o < 64; o <<= 1) v += __shfl_xor(v, o);
    return v;
}
__device__ __forceinline__ float row_rstd(const float* part, int row) {
    const f32x4* p = (const f32x4*)(part + (size_t)row * NPART); f32x4 s = p[0];
#pragma unroll
    for (int i = 1; i < NPART / 4; ++i) s += p[i];
    const float t = (s.x + s.y) + (s.z + s.w);
    return __builtin_amdgcn_rsqf(t * (1.0f / DM) + RMS_EPS);
}

namespace pg8 {
constexpr int BM = 256, BK = 64, HALF = 128, HTB = HALF * BK * 2, NXCD = 8, WGM = 8;
__host__ __device__ __forceinline__ int lds_byte(int r, int c) { const int st = (r >> 4) * 2 + (c >> 5), rr = r & 15, cc = c & 31, ob = rr * 64 + cc * 2; return st * 1024 + (ob ^ (((ob >> 9) & 1) << 5)); }
__host__ __device__ __forceinline__ void stage_rc(int b, int& R, int& C) { const int st = b / 1024, sb = b % 1024, swz = sb ^ (((sb >> 9) & 1) << 5); R = (st >> 1) * 16 + swz / 64; C = (st & 1) * 32 + (swz % 64) / 2; }
__host__ __device__ __forceinline__ int perm32(int rho) { const int n = rho >> 4, i = rho & 15; return 8 * (i >> 2) + 4 * n + (i & 3); }

struct Unit { int pm, pn; };
struct Gemm { const char* A; const char* B; int lda, ldbN, K, nM, nN, gs, gm; unsigned agrp, bgrp; };
__device__ __forceinline__ const char* tileA(const Gemm& g, const Unit& u) { return g.A + (size_t)u.pm * 256 * g.lda * 2 + (size_t)(u.pn >> g.gs) * g.agrp; }
__device__ __forceinline__ const char* tileB(const Gemm& g, const Unit& u) { return g.B + (size_t)(u.pn >> g.gs) * g.bgrp + (size_t)(u.pn & g.gm) * 256 * 64; }

struct StaticOrder {
    int nM, nN, nwg, G, c;
    __device__ void init(int nM_, int nN_, int G_, int c_) { nM = nM_; nN = nN_; nwg = nM * nN; G = G_; c = c_; }
    __device__ bool next(int i, Unit& u) const {
        const long L = (long)i * G + c; if (L >= nwg) return false;
        int wgid = (int)L; { const int q = nwg / NXCD, r = nwg % NXCD, xcd = wgid % NXCD, off = wgid / NXCD; wgid = (xcd < r ? xcd * (q + 1) : r * (q + 1) + (xcd - r) * q) + off; }
        const int nig = WGM * nN, gid = wgid / nig, fm = gid * WGM, gsz = (nM - fm) < WGM ? (nM - fm) : WGM;
        u.pm = fm + ((wgid % nig) % gsz); u.pn = (wgid % nig) / gsz; return true;
    }
};

template <class Epi, bool ALIGN_EPI>
__device__ __forceinline__ void gemm_phase(LAS unsigned char* lds, const Gemm g, int G, int cid, const Epi& E) {
    int tid = threadIdx.x; asm volatile("" : "+v"(tid));
    const int wid = __builtin_amdgcn_readfirstlane(tid >> 6), lane = tid & 63, wr = wid >> 2, wc = wid & 3, fr = lane & 15, fq = lane >> 4;
    const int K = g.K, nt = K / BK;
    StaticOrder S; S.init(g.nM, g.nN, G, cid);
    unsigned voffA[2], voffB[2];
#pragma unroll
    for (int i = 0; i < 2; ++i) { int R, C; stage_rc(tid * 16 + i * 8192, R, C); const int Rb = (R & ~31) + perm32(R & 31);
        voffA[i] = (unsigned)(R * g.lda + C) * 2u; voffB[i] = (unsigned)((C >> 5) * g.ldbN + Rb) * 64u + (unsigned)(C & 31) * 2u; }
    const size_t kA = (size_t)(BK * 2), kB = (size_t)2 * g.ldbN * 64;
    const size_t hA = (size_t)HALF * g.lda * 2, hB = (size_t)HALF * 64;
    const unsigned ldsw = (unsigned)wid * 1024u;
    const int aoff = lds_byte(wr * 64 + fr, fq * 8), boff = lds_byte(wc * 32 + fr, fq * 8);
#define PG8_SA(b, h) (((b) * 2 + (h)) * HTB)
#define PG8_SB(b, h) ((4 + (b) * 2 + (h)) * HTB)
#define PG8_STAGE(bufoff, gbase, voff) do { _Pragma("unroll") for (int _i = 0; _i < 2; ++_i) \
        __builtin_amdgcn_global_load_lds((const unsigned*)((const char*)(gbase) + (voff)[_i]), (LAS unsigned*)(lds + (bufoff) + ldsw + _i * 8192), 16, 0, 0); } while (0)
#define PG8_LDA(dst, b, h) do { _Pragma("unroll") for (int m = 0; m < 4; ++m) _Pragma("unroll") for (int k = 0; k < 2; ++k) dst[m][k] = *(const LAS bf16x8*)(lds + PG8_SA(b, h) + aoff + m * 2048 + k * 1024); } while (0)
#define PG8_LDB(dst, b, h) do { _Pragma("unroll") for (int n = 0; n < 2; ++n) _Pragma("unroll") for (int k = 0; k < 2; ++k) dst[n][k] = *(const LAS bf16x8*)(lds + PG8_SB(b, h) + boff + n * 2048 + k * 1024); } while (0)
#define PG8_MMA(ai, bj, At, Bt) do { __builtin_amdgcn_s_setprio(1); _Pragma("unroll") for (int m = 0; m < 4; ++m) _Pragma("unroll") for (int n = 0; n < 2; ++n) _Pragma("unroll") for (int k = 0; k < 2; ++k) \
        acc[ai][bj][m][n] = __builtin_amdgcn_mfma_f32_16x16x32_bf16(Bt[n][k], At[m][k], acc[ai][bj][m][n], 0, 0, 0); __builtin_amdgcn_s_setprio(0); } while (0)
#define PG8_WAIT_V(n) asm volatile("s_waitcnt vmcnt(" #n ")" ::: "memory")
#define PG8_WAIT_L(n) asm volatile("s_waitcnt lgkmcnt(" #n ")" ::: "memory")
#define PG8_BAR __builtin_amdgcn_s_barrier()
#define PG8_SCHED __builtin_amdgcn_sched_barrier(0)
    Unit cur, nxt; int ui = 0;
    if (!S.next(0, cur)) return;
    LAS float* rtab = (LAS float*)(lds + 8 * HTB);
#define PG8_RTAB_FILL() do { if constexpr (Epi::ROWSCALE) { if (tid < 256) rtab[(ui & 1) * 256 + tid] = row_rstd(E.part, cur.pm * 256 + tid); } } while (0)
    PG8_RTAB_FILL();
    f32x4 acc[2][2][4][2];
#pragma unroll
    for (int a = 0; a < 2; ++a)
#pragma unroll
        for (int b = 0; b < 2; ++b)
#pragma unroll
            for (int m = 0; m < 4; ++m)
#pragma unroll
                for (int n = 0; n < 2; ++n) acc[a][b][m][n] = (f32x4){0.f, 0.f, 0.f, 0.f};
    bf16x8 At[4][2], B0[2][2], B1[2][2];
    const char* cA = tileA(g, cur); const char* cB = tileB(g, cur);
    PG8_STAGE(PG8_SB(0, 0), cB, voffB); PG8_STAGE(PG8_SB(0, 1), cB + hB, voffB); PG8_STAGE(PG8_SA(0, 0), cA, voffA); PG8_STAGE(PG8_SA(0, 1), cA + hA, voffA);
    if (wr == 1) PG8_BAR;
    PG8_WAIT_V(2); PG8_BAR;
    PG8_STAGE(PG8_SB(1, 0), cB + kB, voffB); PG8_STAGE(PG8_SA(1, 0), cA + kA, voffA); PG8_STAGE(PG8_SB(1, 1), cB + hB + kB, voffB);
    PG8_WAIT_V(6); PG8_BAR;
    for (;;) {
        const bool has_next = S.next(ui + 1, nxt);
        const char* nA = has_next ? tileA(g, nxt) : cA; const char* nB = has_next ? tileB(g, nxt) : cB;
        for (int t = 0; t < nt; t += 2) {
            const bool last = (t == nt - 2);
            const char* a1 = cA + (size_t)(t + 1) * kA;
            const char* a2 = last ? nA : cA + (size_t)(t + 2) * kA; const char* b2 = last ? nB : cB + (size_t)(t + 2) * kB;
            const char* a3 = a2 + kA; const char* b3 = b2 + kB;
            PG8_LDB(B0, 0, 0); PG8_LDB(B1, 0, 1); PG8_SCHED; PG8_LDA(At, 0, 0); PG8_STAGE(PG8_SA(1, 1), a1 + hA, voffA);
            PG8_WAIT_V(8); PG8_WAIT_L(0); PG8_BAR; PG8_MMA(0, 0, At, B0); PG8_MMA(0, 1, At, B1); PG8_BAR; PG8_SCHED;
            PG8_LDA(At, 0, 1); PG8_STAGE(PG8_SB(0, 0), b2, voffB); PG8_STAGE(PG8_SB(0, 1), b2 + hB, voffB); PG8_STAGE(PG8_SA(0, 0), a2, voffA);
            PG8_WAIT_V(8); PG8_WAIT_L(0); PG8_BAR; PG8_MMA(1, 0, At, B0); PG8_MMA(1, 1, At, B1); PG8_BAR; PG8_SCHED;
            PG8_LDB(B0, 1, 0); PG8_LDB(B1, 1, 1); PG8_SCHED; PG8_LDA(At, 1, 0); PG8_STAGE(PG8_SA(0, 1), a2 + hA, voffA);
            PG8_WAIT_V(8); PG8_WAIT_L(0); PG8_BAR; PG8_MMA(0, 0, At, B0); PG8_MMA(0, 1, At, B1); PG8_BAR; PG8_SCHED;
            PG8_LDA(At, 1, 1); PG8_STAGE(PG8_SB(1, 0), b3, voffB); PG8_STAGE(PG8_SB(1, 1), b3 + hB, voffB); PG8_STAGE(PG8_SA(1, 0), a3, voffA);
            PG8_WAIT_V(8); PG8_WAIT_L(0); PG8_BAR; PG8_MMA(1, 0, At, B0); PG8_MMA(1, 1, At, B1); PG8_BAR; PG8_SCHED;
        }
        if constexpr (ALIGN_EPI) { if (wr == 0) PG8_BAR; }
        f32x4 rl[NPART / 4];
#pragma unroll
        for (int i = 0; i < NPART / 4; ++i) rl[i] = (f32x4){0.f, 0.f, 0.f, 0.f};
        if constexpr (Epi::ROWSCALE) { if (has_next && tid < 256) { const f32x4* p_ = (const f32x4*)(E.part + (size_t)(nxt.pm * 256 + tid) * NPART);
#pragma unroll
            for (int i = 0; i < NPART / 4; ++i) rl[i] = p_[i]; } }
        E(acc, cur, wr, wc, fr, fq, rtab + (ui & 1) * 256);
        if (!has_next) break;
        if constexpr (Epi::ROWSCALE) { if (tid < 256) { f32x4 s_ = rl[0];
#pragma unroll
            for (int i = 1; i < NPART / 4; ++i) s_ += rl[i];
            rtab[((ui + 1) & 1) * 256 + tid] = __builtin_amdgcn_rsqf(((s_.x + s_.y) + (s_.z + s_.w)) * (1.0f / DM) + RMS_EPS); } }
#pragma unroll
        for (int a = 0; a < 2; ++a)
#pragma unroll
            for (int b = 0; b < 2; ++b)
#pragma unroll
                for (int m = 0; m < 4; ++m)
#pragma unroll
                    for (int n = 0; n < 2; ++n) acc[a][b][m][n] = (f32x4){0.f, 0.f, 0.f, 0.f};
        cur = nxt; cA = nA; cB = nB; ++ui;
        if constexpr (ALIGN_EPI) { if (wr == 1) PG8_BAR; }
    }
    PG8_WAIT_V(0);
    if constexpr (!ALIGN_EPI) { if (wr == 0) PG8_BAR; }
    PG8_BAR;
#undef PG8_RTAB_FILL
#undef PG8_SA
#undef PG8_SB
#undef PG8_STAGE
#undef PG8_LDA
#undef PG8_LDB
#undef PG8_MMA
#undef PG8_WAIT_V
#undef PG8_WAIT_L
#undef PG8_BAR
#undef PG8_SCHED
}

struct EpiQKV {
    static constexpr bool ROWSCALE = true;
    bf16_t* QKV; const float* part; LAS float* ex  ; const LAS float* gtab  ;
    __device__ __forceinline__ void operator()(const f32x4 (&acc)[2][2][4][2], const Unit& u, int wr, int wc, int fr, int fq, const LAS float* rt) const {
        const int row0 = u.pm * BM + wr * 64 + fr;
        const bool qk = u.pn < 16;
        if (qk) {
#pragma unroll
            for (int ai = 0; ai < 2; ++ai)
#pragma unroll
                for (int m = 0; m < 4; ++m) { const int rl = ai * HALF + wr * 64 + m * 16 + fr; const float rs = rt[rl];
#pragma unroll
                    for (int bj = 0; bj < 2; ++bj) { const f32x4 v0 = acc[ai][bj][m][0] * rs, v1 = acc[ai][bj][m][1] * rs;
                        float s = (v0[0] * v0[0] + v0[1] * v0[1]) + (v0[2] * v0[2] + v0[3] * v0[3]) + (v1[0] * v1[0] + v1[1] * v1[1]) + (v1[2] * v1[2] + v1[3] * v1[3]);
                        s += __shfl_xor(s, 16); s += __shfl_xor(s, 32);
                        if (fq == 0) ex[(rl * 2 + bj) * 4 + wc] = s; } }
            asm volatile("s_waitcnt lgkmcnt(0)" ::: "memory"); __builtin_amdgcn_s_barrier(); asm volatile("" ::: "memory");
        }
        f32x4 g0 = (f32x4){1.f, 1.f, 1.f, 1.f}, g1 = g0;
        if (qk) { const LAS float* gp = gtab + (u.pn >= 8 ? 128 : 0) + wc * 32 + 8 * fq; g0 = *(const LAS f32x4*)gp; g1 = *(const LAS f32x4*)(gp + 4); }
#pragma unroll
        for (int ai = 0; ai < 2; ++ai)
#pragma unroll
            for (int m = 0; m < 4; ++m) { const int rl = ai * HALF + wr * 64 + m * 16 + fr; const int row = row0 + ai * HALF + m * 16; const float rs = rt[rl];
#pragma unroll
                for (int bj = 0; bj < 2; ++bj) { float sc = rs;
                    if (qk) { const f32x4 p = *(const LAS f32x4*)(ex + (rl * 2 + bj) * 4); sc = rs * __builtin_amdgcn_rsqf(((p[0] + p[1]) + (p[2] + p[3])) * (1.0f / HD) + RMS_EPS); }
                    const f32x4 v0 = acc[ai][bj][m][0] * sc * g0, v1 = acc[ai][bj][m][1] * sc * g1;
                    u32x4 w; w.x = cvt_pk_bf16(v0[0], v0[1]); w.y = cvt_pk_bf16(v0[2], v0[3]); w.z = cvt_pk_bf16(v1[0], v1[1]); w.w = cvt_pk_bf16(v1[2], v1[3]);
                    *(u32x4*)(QKV + ((size_t)(2 * u.pn + bj) * S + row) * HD + wc * 32 + 8 * fq) = w; } }
    }
};
struct EpiGateUp {
    static constexpr bool ROWSCALE = true;
    bf16_t* H; const float* part;
    __device__ __forceinline__ void operator()(const f32x4 (&acc)[2][2][4][2], const Unit& u, int wr, int wc, int fr, int fq, const LAS float* rt) const {
        const int row0 = u.pm * BM + wr * 64 + fr;
#pragma unroll
        for (int ai = 0; ai < 2; ++ai)
#pragma unroll
            for (int m = 0; m < 4; ++m) { const int row = row0 + ai * HALF + m * 16; const float rs = rt[ai * HALF + wr * 64 + m * 16 + fr];
                const f32x4 g0 = acc[ai][0][m][0] * rs, g1 = acc[ai][0][m][1] * rs, u0 = acc[ai][1][m][0] * rs, u1 = acc[ai][1][m][1] * rs;
                f32x4 e0 = g0 * (-LOG2E), e1 = g1 * (-LOG2E);
#pragma unroll
                for (int i = 0; i < 4; ++i) { e0[i] = __builtin_amdgcn_exp2f(e0[i]); e1[i] = __builtin_amdgcn_exp2f(e1[i]); }
                e0 += 1.0f; e1 += 1.0f;
#pragma unroll
                for (int i = 0; i < 4; ++i) { e0[i] = __builtin_amdgcn_rcpf(e0[i]); e1[i] = __builtin_amdgcn_rcpf(e1[i]); }
                const f32x4 o0 = g0 * e0 * u0, o1 = g1 * e1 * u1;
                u32x4 w; w.x = cvtpk_s(o0[0], o0[1]); w.y = cvtpk_s(o0[2], o0[3]); w.z = cvtpk_s(o1[0], o1[1]); w.w = cvtpk_s(o1[2], o1[3]);
                *(u32x4*)(H + (size_t)row * FF + u.pn * HALF + wc * 32 + 8 * fq) = w; }
    }
};
template <bool HB  >
struct EpiResid {
    static constexpr bool ROWSCALE = false;
    const float* Xs; float* X; bf16_t* XB; float* part; const float* bias; const float* scale; bool feeds;
    __device__ __forceinline__ void operator()(const f32x4 (&acc)[2][2][4][2], const Unit& u, int wr, int wc, int fr, int fq, const LAS float*) const {
        const int row0 = u.pm * BM + wr * 64 + fr, col0 = u.pn * BM + wc * 32 + 8 * fq;
        f32x4 bv[2][2], sv[2][2];
#pragma unroll
        for (int bj = 0; bj < 2; ++bj)
#pragma unroll
            for (int n = 0; n < 2; ++n) { bv[bj][n] = HB ? *(const f32x4*)(bias + col0 + bj * HALF + 4 * n) : (f32x4){0.f, 0.f, 0.f, 0.f};
                                           sv[bj][n] = HB ? *(const f32x4*)(scale + col0 + bj * HALF + 4 * n) : (f32x4){1.f, 1.f, 1.f, 1.f}; }
        constexpr int NB = HB ? 4 : 2, MB = 4 / (NB / 2);
#pragma unroll
        for (int am = 0; am < NB; ++am) { const int ai = am / (NB / 2), m0 = (am % (NB / 2)) * MB;
            f32x4 xo[4][2][2];
#pragma unroll
            for (int m = m0; m < m0 + MB; ++m) { const float* xr = Xs + (size_t)(row0 + ai * HALF + m * 16) * DM + col0;
#pragma unroll
                for (int bj = 0; bj < 2; ++bj) { xo[m][bj][0] = *(const f32x4*)(xr + bj * HALF); xo[m][bj][1] = *(const f32x4*)(xr + bj * HALF + 4); } }
#pragma unroll
            for (int m = m0; m < m0 + MB; ++m) { const int row = row0 + ai * HALF + m * 16; float ss = 0.f;
                float* xr = X + (size_t)row * DM + col0; bf16_t* xb = XB + (size_t)row * ALD + col0;
#pragma unroll
                for (int bj = 0; bj < 2; ++bj) { f32x4 x0 = xo[m][bj][0], x1 = xo[m][bj][1];
                    if (HB) { x0 += (acc[ai][bj][m][0] + bv[bj][0]) * sv[bj][0]; x1 += (acc[ai][bj][m][1] + bv[bj][1]) * sv[bj][1]; } else { x0 += acc[ai][bj][m][0]; x1 += acc[ai][bj][m][1]; }
                    *(f32x4*)(xr + bj * HALF) = x0; *(f32x4*)(xr + bj * HALF + 4) = x1;
                    ss += (x0[0] * x0[0] + x0[1] * x0[1]) + (x0[2] * x0[2] + x0[3] * x0[3]) + (x1[0] * x1[0] + x1[1] * x1[1]) + (x1[2] * x1[2] + x1[3] * x1[3]);
                    u32x4 w; w.x = cvt_pk_bf16(x0[0], x0[1]); w.y = cvt_pk_bf16(x0[2], x0[3]); w.z = cvt_pk_bf16(x1[0], x1[1]); w.w = cvt_pk_bf16(x1[2], x1[3]);
                    if (feeds) *(u32x4*)(xb + bj * HALF) = w; }
                ss += __shfl_xor(ss, 16); ss += __shfl_xor(ss, 32);
                if (fq == 0 && feeds) part[(size_t)row * NPART + u.pn * 4 + wc] = ss; }
        }
    }
};
}

namespace att {
constexpr int D = 128, NW = 8, QBLK = 32, KVBLK = 64, QB = NW * QBLK;
constexpr int SHM_V = KVBLK * D * 2, SHM_K = KVBLK * D * 2;
constexpr int OFF_WS = 2 * SHM_V + 2 * SHM_K, OFF_CB = OFF_WS + NW * 64 * 4, OFF_Q = OFF_CB + 2 * 64 * 4, ATT_LDS = OFF_Q + NW * 8192;
static_assert(ATT_LDS <= LDS_BYTES, "attention LDS");
typedef const volatile LAS bf16x8* qlds_t;
constexpr int OSTR = ALD;
constexpr float THR2 = 64.0f;
#define KSWZ(row, colB) ((row) * 256 + ((colB) ^ (((row) & 7) << 4)))
#define SBAR() __builtin_amdgcn_sched_barrier(0)
__device__ __forceinline__ int v_st(int k, int c) { const int kk = (k & ~0xC) | ((k & 4) << 1) | ((k & 8) >> 1); return ((kk >> 3) * 4 + (c >> 5)) * 512 + ((kk & 7) * 32 + (c & 31)) * 2; }
__device__ __forceinline__ int v_rd_base(int lane) { return ((lane & 3) << 3) | (((lane >> 2) & 3) << 6) | (((lane >> 4) & 1) << 5) | (((lane >> 5) & 1) << 8); }
constexpr int v_rd_off(int d0, int ks, int half) { return d0 * 512 + ks * 4096 + half * 2048; }
__device__ __forceinline__ int crow(int r, int hi) { return (r & 3) + 8 * (r >> 2) + 4 * hi; }
__device__ __forceinline__ bf16x8 load8(const bf16_t* p) { return *reinterpret_cast<const bf16x8*>(p); }
__device__ __forceinline__ void mask_tile(f32x16& p0, f32x16& p1, int dq, unsigned W) {
    const float NEG = -__builtin_inff();
#pragma unroll
    for (int r = 0; r < 16; ++r) {
        const int c = (r & 3) + 8 * (r >> 2);
        if ((unsigned)(dq - c) >= W) p0[r] = NEG;
        if ((unsigned)(dq - c - 32) >= W) p1[r] = NEG;
    }
}
__device__ __forceinline__ void partialSM(f32x16& p0, f32x16& p1, float& m_reg, float& mn, float& alpha) {
    float pmax = p0[0];
#pragma unroll
    for (int r = 1; r < 16; ++r) pmax = fmaxf(pmax, p0[r]);
#pragma unroll
    for (int r = 0; r < 16; ++r) pmax = fmaxf(pmax, p1[r]);
    { auto rr = __builtin_amdgcn_permlane32_swap(__float_as_uint(pmax), __float_as_uint(pmax), false, false);
      pmax = fmaxf(__uint_as_float(rr[0]), __uint_as_float(rr[1])); }
    if (__builtin_expect(__all((pmax - m_reg) <= THR2), 1)) { mn = m_reg; alpha = 1.f; }
    else { mn = fmaxf(m_reg, pmax); alpha = __builtin_amdgcn_exp2f(m_reg - mn); m_reg = mn; }
#pragma unroll
    for (int r = 0; r < 16; ++r) { p0[r] -= mn; p1[r] -= mn; }
#pragma unroll
    for (int r = 0; r < 16; ++r) p0[r] = __builtin_amdgcn_exp2f(p0[r]);
}
__device__ __forceinline__ void finishSM(f32x16& p0, f32x16& p1, float alpha, float& l_reg, bf16x8& pa0, bf16x8& pa1, bf16x8& pa2, bf16x8& pa3) {
#pragma unroll
    for (int r = 0; r < 16; ++r) p1[r] = __builtin_amdgcn_exp2f(p1[r]);
    float ps = 0;
#pragma unroll
    for (int r = 0; r < 16; ++r) ps += p0[r];
#pragma unroll
    for (int r = 0; r < 16; ++r) ps += p1[r];
    { auto rr = __builtin_amdgcn_permlane32_swap(__float_as_uint(ps), __float_as_uint(ps), false, false);
      ps = __uint_as_float(rr[0]) + __uint_as_float(rr[1]); }
    l_reg = l_reg * alpha + ps;
#define PK4(P, B_, OUT) do { unsigned a0 = cvt_pk_bf16(P[B_+0], P[B_+1]), a1 = cvt_pk_bf16(P[B_+2], P[B_+3]);                          \
        unsigned b0 = cvt_pk_bf16(P[B_+4], P[B_+5]), b1 = cvt_pk_bf16(P[B_+6], P[B_+7]);                                             \
        auto r0 = __builtin_amdgcn_permlane32_swap(a0, b0, false, false); auto r1 = __builtin_amdgcn_permlane32_swap(a1, b1, false, false); \
        u32x4 w = {r0[0], r1[0], r0[1], r1[1]}; OUT = *reinterpret_cast<bf16x8*>(&w); } while (0)
    PK4(p0, 0, pa0); PK4(p0, 8, pa1); PK4(p1, 0, pa2); PK4(p1, 8, pa3);
#undef PK4
}
template <int KB>
__device__ __forceinline__ void qkt(f32x16& p0, f32x16& p1, const char* K_lds, const float* cb_l, int r32, int hi, qlds_t qL) {
    { const float* cbt = cb_l + KB * 64 + 4 * hi;
#pragma unroll
      for (int g4 = 0; g4 < 4; ++g4) { const f32x4 b0 = *(const f32x4*)(cbt + 8 * g4), b1 = *(const f32x4*)(cbt + 32 + 8 * g4);
#pragma unroll
          for (int i = 0; i < 4; ++i) { p0[4 * g4 + i] = b0[i]; p1[4 * g4 + i] = b1[i]; } } }
    const char* kb[4];
#pragma unroll
    for (int dd = 0; dd < 4; ++dd) kb[dd] = K_lds + KB * SHM_K + KSWZ(r32, (dd * 16 + hi * 8) * 2);
#pragma unroll
    for (int d0 = 0; d0 < 8; ++d0) { const char* a = kb[d0 & 3] + (d0 >> 2) * 128;
        bf16x8 b0 = *reinterpret_cast<const bf16x8*>(a);
        bf16x8 b1 = *reinterpret_cast<const bf16x8*>(a + 32 * 256);
        const bf16x8 q = qL[d0 * 64];
        p0 = __builtin_amdgcn_mfma_f32_32x32x16_bf16(b0, q, p0, 0, 0, 0);
        p1 = __builtin_amdgcn_mfma_f32_32x32x16_bf16(b1, q, p1, 0, 0, 0); }
}
template <int VB>
__device__ __forceinline__ void pv_tile(f32x16* o, int vb0, bf16x8 pa0, bf16x8 pa1, bf16x8 pa2, bf16x8 pa3) {
#define TRRD(dst, off) asm volatile("ds_read_b64_tr_b16 %0, %1 offset:%2" : "=&v"(dst) : "v"(vb0), "i"(off) : "memory")
#define PV_D0(d0) do { s16x4 l0, l1, l2, l3, h0, h1, h2, h3; constexpr int b_ = VB * SHM_V + v_rd_off(d0, 0, 0); \
        TRRD(l0, b_); TRRD(h0, b_ + 2048); TRRD(l1, b_ + 4096); TRRD(h1, b_ + 6144); TRRD(l2, b_ + 8192); TRRD(h2, b_ + 10240); TRRD(l3, b_ + 12288); TRRD(h3, b_ + 14336); \
        asm volatile("s_waitcnt lgkmcnt(0)" ::: "memory"); SBAR();   \
        o[d0] = __builtin_amdgcn_mfma_f32_32x32x16_bf16(pa0, (bf16x8){l0[0], l0[1], l0[2], l0[3], h0[0], h0[1], h0[2], h0[3]}, o[d0], 0, 0, 0);   \
        o[d0] = __builtin_amdgcn_mfma_f32_32x32x16_bf16(pa1, (bf16x8){l1[0], l1[1], l1[2], l1[3], h1[0], h1[1], h1[2], h1[3]}, o[d0], 0, 0, 0);   \
        o[d0] = __builtin_amdgcn_mfma_f32_32x32x16_bf16(pa2, (bf16x8){l2[0], l2[1], l2[2], l2[3], h2[0], h2[1], h2[2], h2[3]}, o[d0], 0, 0, 0);   \
        o[d0] = __builtin_amdgcn_mfma_f32_32x32x16_bf16(pa3, (bf16x8){l3[0], l3[1], l3[2], l3[3], h3[0], h3[1], h3[2], h3[3]}, o[d0], 0, 0, 0); } while (0)
    PV_D0(0); PV_D0(1); PV_D0(2); PV_D0(3);
#undef PV_D0
#undef TRRD
}
struct BlockRef { const bf16_t* Q; const bf16_t* K; const bf16_t* V; const float* CB; bf16_t* O; int P0; int jlo; };
struct Seam { bf16x8 qr[8]; bf16x8 st_v0, st_v1, st_k0, st_k1; float st_c; };
__device__ __forceinline__ int swa_jlo(int P0, int W) { const int lowk = P0 - W + 1; return lowk > 0 ? lowk / KVBLK : 0; }
#define ROW(p, k0, rr) ((p) + (size_t)((k0) + (rr)) * D + sc)
#define VMW() asm volatile("s_waitcnt vmcnt(0)" ::: "memory")
#define VMWN(n) asm volatile("s_waitcnt vmcnt(%0)" :: "i"(n) : "memory")
#define SLOAD_H(Kp, Vp, Cp, k0) do { const char* vb_ = (const char*)(Vp) + (size_t)(k0) * (D * 2); const char* kb_ = (const char*)(Kp) + (size_t)(k0) * (D * 2);     \
                         S.st_v0 = *(const bf16x8*)(vb_ + loff); S.st_v1 = *(const bf16x8*)(vb_ + 32 * D * 2 + loff);              \
                         S.st_k0 = *(const bf16x8*)(kb_ + loff); S.st_k1 = *(const bf16x8*)(kb_ + 32 * D * 2 + loff); S.st_c = *(const float*)((const char*)((Cp) + (k0)) + lane4); } while (0)
#define SWRITE_HK(bf) do { *(bf16x8*)(K_lds + (bf) * SHM_K + kws) = S.st_k0; *(bf16x8*)(K_lds + (bf) * SHM_K + kws + 32 * 256) = S.st_k1; cb_l[(bf) * 64 + lane] = S.st_c; } while (0)
#define SWRITE_HV(bf) do { *(bf16x8*)(V_lds + (bf) * SHM_V + vst0) = S.st_v0; *(bf16x8*)(V_lds + (bf) * SHM_V + vst1) = S.st_v1; } while (0)
#define SWRITE_H(bf) do { SWRITE_HV(bf); SWRITE_HK(bf); } while (0)
__device__ __forceinline__ void causal_prime(const BlockRef& cur, int W, char* lds, Seam& S) {
    int tid = threadIdx.x; asm volatile("" : "+v"(tid));
    const int wid = __builtin_amdgcn_readfirstlane(tid >> 6), lane = tid & 63, r32 = lane & 31, hi = lane >> 5;
    const int sr = tid >> 4, sc = (tid & 15) * 8, kws = KSWZ(sr, sc * 2); char* K_lds = lds + 2 * SHM_V; float* cb_l = (float*)(lds + OFF_CB);
    const unsigned loff = (unsigned)(sr * D + sc) * 2u, lane4 = (unsigned)lane * 4u;
    const int kb0 = cur.jlo * KVBLK;
#pragma unroll
    for (int d0 = 0; d0 < 8; ++d0) S.qr[d0] = load8(cur.Q + (size_t)(wid * QBLK + r32) * D + d0 * 16 + hi * 8);
    SLOAD_H(cur.K, cur.V, cur.CB, kb0); VMW(); SWRITE_HK(0);
    __syncthreads();
}
__device__ __forceinline__ void causal_block(const BlockRef& cur, const BlockRef& nxt, int skv, int W, char* lds, Seam& S) {
    int tid = threadIdx.x; asm volatile("" : "+v"(tid));
    const int wid = __builtin_amdgcn_readfirstlane(tid >> 6), lane = tid & 63, r32 = lane & 31, hi = lane >> 5;
    const int j_lo = cur.jlo;
    int j_hi = (cur.P0 + QB - 1) / KVBLK + 1; if (j_hi > skv / KVBLK) j_hi = skv / KVBLK;
    const int NT = j_hi - j_lo;
    const int kbn = nxt.jlo * KVBLK;
    const int qlo = cur.P0 + wid * QBLK, qm = qlo + r32 - 4 * hi;
    char* V_lds = lds; char* K_lds = lds + 2 * SHM_V; float* cb_l = (float*)(lds + OFF_CB);
    float* ws = (float*)(lds + OFF_WS) + wid * 64; float* li_l = ws, * al_l = ws + 32;
    float m_reg = -1e30f, l_reg = 0; f32x16 o[4] = {};
    const int sr = tid >> 4, sc = (tid & 15) * 8, vst0 = v_st(sr, sc), vst1 = v_st(32 + sr, sc), kws = KSWZ(sr, sc * 2);
    const int vb0 = (int)(uintptr_t)V_lds + v_rd_base(lane);
    const unsigned loff = (unsigned)(sr * D + sc) * 2u, lane4 = (unsigned)lane * 4u;
    const bf16_t* Kh = cur.K; const bf16_t* Vh = cur.V; const float* Ch = cur.CB;
#define RESC(a) do { if (__any((a) < 1.f)) { if (hi == 0) al_l[r32] = (a); asm volatile("s_waitcnt lgkmcnt(0)" ::: "memory");              \
                     for (int d_ = 0; d_ < 4; ++d_) for (int r = 0; r < 16; ++r) o[d_][r] *= al_l[crow(r, hi)]; } } while (0)
#define KBASE(t) ((j_lo + (t)) * KVBLK)
#define MASKT(P0_, P1_, t) do { const int kb_ = KBASE(t); if (kb_ + KVBLK - 1 > qlo || kb_ <= qlo + QBLK - 1 - W) mask_tile(P0_, P1_, qm - kb_, (unsigned)W); } while (0)
    constexpr int NQL = 8;
#define SEAM_K0() do { VMWN(NQL); SWRITE_HK(0); SBAR(); } while (0)
    f32x16 pA0, pA1, pB0, pB1; float mnA, mnB, alA, alB; bf16x8 pa0, pa1, pa2, pa3;
    LAS bf16x8* qW = (LAS bf16x8*)((LAS unsigned char*)0 + OFF_Q + wid * 8192) + lane;
#pragma unroll
    for (int d0 = 0; d0 < 8; ++d0) qW[d0 * 64] = S.qr[d0];
    const qlds_t qL = (qlds_t)qW;
    SWRITE_HV(0); SBAR();
    if (NT > 1) { SLOAD_H(Kh, Vh, Ch, KBASE(1)); }
    SBAR(); qkt<0>(pA0, pA1, K_lds, cb_l, r32, hi, qL);
    MASKT(pA0, pA1, 0); partialSM(pA0, pA1, m_reg, mnA, alA);
    if (NT > 1) { VMW(); SWRITE_H(1); }
    __syncthreads();
#define HALF_STEP(PX0, PX1, mnX, alX, PY0, PY1, alY, t, KB, VB, SB) do {                                                      \
        SBAR(); qkt<KB>(PX0, PX1, K_lds, cb_l, r32, hi, qL);                                             \
        finishSM(PY0, PY1, alY, l_reg, pa0, pa1, pa2, pa3); SBAR();                                                           \
        if ((t) + 1 < NT) { SLOAD_H(Kh, Vh, Ch, KBASE((t) + 1)); SBAR(); }                                               \
        pv_tile<VB>(o, vb0, pa0, pa1, pa2, pa3); MASKT(PX0, PX1, (t)); partialSM(PX0, PX1, m_reg, mnX, alX);                                        \
        __syncthreads();                                                                                                      \
        if ((t) + 1 < NT) { VMW(); SWRITE_H(SB); }                                                                          \
        RESC(alX); __syncthreads(); } while (0)
    for (int t = 1; t + 1 < NT; t += 2) {
        HALF_STEP(pB0, pB1, mnB, alB, pA0, pA1, alA, t, 1, 0, 0);
        HALF_STEP(pA0, pA1, mnA, alA, pB0, pB1, alB, t + 1, 0, 1, 1);
    }
    const bool even = (NT & 1) == 0;
    if (even) { SBAR(); qkt<1>(pB0, pB1, K_lds, cb_l, r32, hi, qL); SBAR(); }
    SLOAD_H(nxt.K, nxt.V, nxt.CB, kbn); SBAR();
#pragma unroll
    for (int d0 = 0; d0 < 8; ++d0) S.qr[d0] = load8(nxt.Q + (size_t)(wid * QBLK + r32) * D + d0 * 16 + hi * 8);
    SBAR();
    finishSM(pA0, pA1, alA, l_reg, pa0, pa1, pa2, pa3); SBAR();
    pv_tile<0>(o, vb0, pa0, pa1, pa2, pa3);
    if (even) { MASKT(pB0, pB1, NT - 1); partialSM(pB0, pB1, m_reg, mnB, alB); __syncthreads(); RESC(alB);
        finishSM(pB0, pB1, alB, l_reg, pa0, pa1, pa2, pa3); SBAR(); pv_tile<1>(o, vb0, pa0, pa1, pa2, pa3); }
    SBAR(); SEAM_K0();
    if (hi == 0) li_l[r32] = l_reg; asm volatile("s_waitcnt lgkmcnt(0)" ::: "memory");
    float rli[16];
#pragma unroll
    for (int r = 0; r < 16; ++r) rli[r] = __builtin_amdgcn_rcpf(li_l[crow(r, hi)]);
    bf16_t* Ow = cur.O + (size_t)(wid * QBLK) * OSTR;
#pragma unroll
    for (int r = 0; r < 16; ++r) { const int orow = crow(r, hi);
#pragma unroll
        for (int d0 = 0; d0 < 4; ++d0) { const float v = o[d0][r] * rli[r];
            const float vn = __shfl_xor(v, 1);
            if ((r32 & 1) == 0) *(unsigned*)(Ow + (size_t)orow * OSTR + d0 * 32 + r32) = cvt_pk_bf16(v, vn); } }
    __syncthreads();
#undef RESC
#undef KBASE
#undef MASKT
#undef SEAM_K0
#undef HALF_STEP
}
#undef ROW
#undef VMW
#undef VMWN
#undef SLOAD_H
#undef SWRITE_HK
#undef SWRITE_HV
#undef SWRITE_H
#undef SBAR
}

#ifndef REP_PRO
#define REP_PRO 1
#endif
#ifndef REP_GU
#define REP_GU 1
#endif
#ifndef REP_Y
#define REP_Y 1
#endif
#ifndef REP_FG
#define REP_FG 1
#endif
#ifndef REP_ATT
#define REP_ATT 1
#endif
#ifndef PH_MASK
#define PH_MASK 0xFFFF
#endif
#define PH(k) (((PH_MASK) >> (k)) & 1)
struct Args { const float* in[13]; float* out; unsigned char* ws; };


#define XB_TMO      128
#define XB_XCNT(j)  (256  + 64 * (j))
#define XB_XSUB(j)  (1280 + 64 * (j))
#define XB_XGEN(j)  (2304 + 64 * (j))
#define XB_TOP      3328
#define XB_TOPGEN   3392
#define XCD_BAR_WORDS 3456
#define XB_SPIN_CAP (1u << 22)
__device__ __forceinline__ unsigned xb_ld(unsigned* p)              { return __hip_atomic_load(p, __ATOMIC_RELAXED, __HIP_MEMORY_SCOPE_AGENT); }
__device__ __forceinline__ unsigned xb_add(unsigned* p, unsigned v) { return __hip_atomic_fetch_add(p, v, __ATOMIC_RELAXED, __HIP_MEMORY_SCOPE_AGENT); }
__device__ __forceinline__ unsigned xb_xcc_id() { return (unsigned)__builtin_amdgcn_s_getreg((3 << 11) | 20) & 0xFu; }
#define XB_SPIN(cond, bar) do { unsigned _sp = 0; while (cond) { __builtin_amdgcn_s_sleep(1); \
    if ((++_sp & 255u) == 0u) { if (xb_ld(&(bar)[XB_TMO])) break; if (_sp > XB_SPIN_CAP) { atomicAdd(&(bar)[XB_TMO], 1u); break; } } } } while (0)
struct XcdBarrier { unsigned* bar; unsigned x; volatile LAS unsigned* st; };
__device__ __forceinline__ XcdBarrier xcd_barrier_post(unsigned* bar, volatile LAS unsigned* st) {
    XcdBarrier b; b.bar = bar; b.x = xb_xcc_id(); b.st = st;
    if (threadIdx.x == 0) (void)xb_add(&bar[XB_XCNT(b.x)], 1u);
    return b;
}
__device__ __forceinline__ void xcd_barrier_complete(unsigned* bar, unsigned x, unsigned& nloc, unsigned& nx) {
    const unsigned G = gridDim.x * gridDim.y * gridDim.z;
    unsigned sum, cnt, mine, sp = 0u;
    for (;;) {
        sum = 0u; cnt = 0u; mine = 0u;
#pragma unroll
        for (unsigned j = 0; j < 16; ++j) { const unsigned c = xb_ld(&bar[XB_XCNT(j)]); sum += c; cnt += (c > 0u) ? 1u : 0u; mine = (j == x) ? c : mine; }
        if (sum == G) break;
        __builtin_amdgcn_s_sleep(1);
        if ((++sp & 255u) == 0u) { if (xb_ld(&bar[XB_TMO])) break; if (sp > XB_SPIN_CAP) { atomicAdd(&bar[XB_TMO], 1u); break; } }
    }
    nloc = mine > 0u ? mine : 1u; nx = cnt > 0u ? cnt : 1u;
}
__device__ __forceinline__ void xcd_barrier(const XcdBarrier& b) {
    asm volatile("s_waitcnt vmcnt(0)" ::: "memory");
    __syncthreads();
    if (threadIdx.x == 0) {
        unsigned* bar = b.bar;
        __builtin_amdgcn_s_waitcnt(0);
        unsigned nloc = b.st[0], nx = b.st[1];
        if (nloc == 0u) { xcd_barrier_complete(bar, b.x, nloc, nx); b.st[0] = nloc; b.st[1] = nx; }
        const unsigned old = xb_add(&bar[XB_XSUB(b.x)], 1u);
        const unsigned gen = old / nloc;
        if (old + 1u == (gen + 1u) * nloc) {
            __builtin_amdgcn_fence(__ATOMIC_RELEASE, "agent");
            asm volatile("s_waitcnt vmcnt(0)" ::: "memory");
            const unsigned og = xb_add(&bar[XB_TOP], 1u);
            const unsigned tg = og / nx;
            if (og + 1u == (tg + 1u) * nx) xb_add(&bar[XB_TOPGEN], 1u);
            else XB_SPIN(xb_ld(&bar[XB_TOPGEN]) == tg, bar);
            __builtin_amdgcn_fence(__ATOMIC_ACQUIRE, "agent");
            xb_add(&bar[XB_XGEN(b.x)], 1u);
            asm volatile("s_waitcnt vmcnt(0)" ::: "memory");
        } else {
            XB_SPIN(xb_ld(&bar[XB_XGEN(b.x)]) == gen, bar);
            __builtin_amdgcn_fence(__ATOMIC_ACQUIRE, "agent");
            asm volatile("s_waitcnt vmcnt(0)" ::: "memory");
        }
    }
    __syncthreads();
}

__device__ __forceinline__ void cg_sync() { cg::this_grid().sync(); }

__device__ __forceinline__ void conv_item(const float* W, int ldw, int Nout, int mode, const float* gk, unsigned char* dst, int item, int lane, LAS unsigned char* wl  ) {
    const int nblk = Nout >> 8, k32 = item / nblk, nb0 = (item - k32 * nblk) * 256, nb = nb0 + lane * 4;
    int sc = nb; if (mode == 1) sc = ((nb >> 7) & 1) * FF + (nb >> 8) * 128 + (nb & 127);
    const float* src = W + (size_t)(k32 * 32) * ldw + sc;
    f32x4 v[32];
#pragma unroll
    for (int i = 0; i < 32; ++i) v[i] = __builtin_nontemporal_load((const f32x4*)(src + (size_t)i * ldw));
    if (gk) {
#pragma unroll
        for (int i = 0; i < 32; ++i) v[i] *= gk[k32 * 32 + i]; }
    LAS unsigned char* mine = wl + lane * 272;
#pragma unroll
    for (int j = 0; j < 4; ++j)
#pragma unroll
        for (int q = 0; q < 4; ++q) { u32x4 w;
            w.x = cvt_pk_bf16(v[8 * q + 0][j], v[8 * q + 1][j]); w.y = cvt_pk_bf16(v[8 * q + 2][j], v[8 * q + 3][j]);
            w.z = cvt_pk_bf16(v[8 * q + 4][j], v[8 * q + 5][j]); w.w = cvt_pk_bf16(v[8 * q + 6][j], v[8 * q + 7][j]);
            *(LAS u32x4*)(mine + (j * 4 + q) * 16) = w; }
    asm volatile("s_waitcnt lgkmcnt(0)" ::: "memory");
    unsigned char* d = dst + ((size_t)k32 * Nout + nb0) * 64 + lane * 16;
    const LAS unsigned char* rd = wl + (lane >> 4) * 272 + (lane & 15) * 16;
#pragma unroll
    for (int s = 0; s < 16; ++s) { const u32x4 w = *(const LAS u32x4*)(rd + s * 4 * 272); *(u32x4*)(d + s * 1024) = w; }
    asm volatile("s_waitcnt lgkmcnt(0)" ::: "memory");
}

__global__ void __launch_bounds__(NTHREADS, 2) fwd_megakernel(Args args) {
    extern __shared__ __attribute__((aligned(16))) unsigned char lds_raw[];
    LAS unsigned char* lds = (LAS unsigned char*)lds_raw;
#define PHASE_IDS() int tid = threadIdx.x; asm volatile("" : "+v"(tid)); const int lane = tid & 63, wid = __builtin_amdgcn_readfirstlane(tid >> 6), gw = vcu * 8 + wid; (void)lane; (void)gw
    const int G = gridDim.x, bx = blockIdx.x;
    const int vcu = (G % 8 == 0) ? (bx % 8) * (G / 8) + bx / 8 : bx;
    const int NGW = G * 8;
    volatile LAS unsigned* bst = (volatile LAS unsigned*)(lds + LDS_BYTES - 16);
    if (threadIdx.x < 2) bst[threadIdx.x] = 0u;
    __syncthreads();
    const XcdBarrier xbar = xcd_barrier_post((unsigned*)args.ws, bst);
#define grid_sync() xcd_barrier(xbar)
    unsigned char* ws = args.ws;
    const float* x_in = args.in[0]; const float* mix_g = args.in[1]; const float* ffn_g = args.in[2];
    const float* w_in = args.in[3]; const float* b_f = args.in[4]; const float* gq = args.in[5]; const float* gk = args.in[6];
    const float* w_out = args.in[7]; const float* pool_w = args.in[8]; const float* pool_b = args.in[9]; const float* pool_s = args.in[10];
    const float* w_gu = args.in[11]; const float* w_dn = args.in[12];
    float* X = args.out;
    float* part = (float*)(ws + WS_PART); float* logf_ = (float*)(ws + WS_LOGF); float* cb = (float*)(ws + WS_CB);
    int* jtab = (int*)(ws + WS_LOGF + 768 * 1024); float* wf_tab = (float*)(ws + WS_CB + 512 * 1024);
    bf16_t* XB = (bf16_t*)(ws + WS_XB); bf16_t* QKV = (bf16_t*)(ws + WS_QKV); bf16_t* OB = (bf16_t*)(ws + WS_O); bf16_t* HB = (bf16_t*)(ws + WS_H);

#define CONV_JOB(W_, ldw_, K_, Nout_, mode_, g_, dst_) do { const int n_ = ((K_) / 32) * ((Nout_) / 256); \
            for (; it < n_; it += nw_c) { const int gi_ = cbase + it; if (gi_ >= clo && gi_ < chi) conv_item(W_, ldw_, Nout_, mode_, g_, dst_, it, lane, lds + wid * 17408); } it -= n_; cbase += n_; } while (0)
#define CONV_LAYER(l_, it0_, nw_, lo_, hi_, mask_) do { const int lc = (l_), jc = lc >> 1, nw_c = (nw_), clo = (lo_), chi = (hi_), mk = (mask_); int it = (it0_), cbase = 0;     \
        if ((lc & 1) == 0) { \
            if (mk & 1) CONV_JOB(w_in + (size_t)jc * DM * WIN_LD, WIN_LD, DM, 3 * DM, 0, mix_g + (size_t)lc * DM, ws + WS_WIN + (size_t)jc * 24 * MiB); \
            if (mk & 8) CONV_JOB(w_out + (size_t)jc * DM * DM, DM, DM, DM, 0, (const float*)nullptr, ws + WS_WOUT + (size_t)jc * 8 * MiB); \
        } else if (mk & 1) { \
            for (int g4 = 0; g4 < 4; ++g4) \
                CONV_JOB(pool_w + ((size_t)jc * 4 + g4) * 512 * 512, 512, 512, 512, 0, (const float*)nullptr, ws + WS_WPOOL + (size_t)jc * 2 * MiB + (size_t)g4 * 512 * 512 * 2); \
        } \
        if (mk & 2) CONV_JOB(w_gu + (size_t)lc * DM * 2 * FF, 2 * FF, DM, 2 * FF, 1, ffn_g + (size_t)lc * DM, ws + WS_WGU + (size_t)lc * 44 * MiB); \
        if (mk & 4) CONV_JOB(w_dn + (size_t)lc * FF * DM, DM, FF, DM, 0, (const float*)nullptr, ws + WS_WDN + (size_t)lc * 22 * MiB); } while (0)
    for (int rep_ = 0; rep_ < REP_PRO; ++rep_) if constexpr (PH(0)) {
        PHASE_IDS();
        CONV_LAYER(0, gw, NGW, 0, 0x7fffffff, 3);
        for (int i = gw * 64 + lane; i < 2 * DM * 4; i += NGW * 64) { const int jf = i >> 13, d = (i >> 2) & (DM - 1), q = i & 3;
            const f32x4 w = *(const f32x4*)(w_in + (size_t)jf * DM * WIN_LD + (size_t)d * WIN_LD + 3 * DM + 4 * q); const float gd = mix_g[(size_t)(2 * jf) * DM + d];
#pragma unroll
            for (int k = 0; k < 4; ++k) wf_tab[((size_t)jf * NH + 4 * q + k) * DM + d] = w[k] * gd; }
        for (int row = gw; row < S; row += NGW) {
            const f32x4* xr = (const f32x4*)(x_in + (size_t)row * DM) + lane;
            u32x2* xb = (u32x2*)(XB + (size_t)row * ALD) + lane; float ss = 0.f;
#pragma unroll
            for (int j = 0; j < 8; ++j) { const f32x4 v = xr[64 * j]; ss += (v.x * v.x + v.y * v.y) + (v.z * v.z + v.w * v.w);
                u32x2 w; w.x = cvt_pk_bf16(v.x, v.y); w.y = cvt_pk_bf16(v.z, v.w); xb[64 * j] = w; }
            ss = wave_sum(ss);
            if (lane < NPART) part[(size_t)row * NPART + lane] = (lane == 0) ? ss : 0.f;
        }
    }
    cg_sync();

#pragma unroll 1
    for (int layer = 0; layer < NLAYER; ++layer) {
        const int j = layer >> 1;
        if ((layer & 1) == 0) {
            for (int rep_ = 0; rep_ < REP_FG; ++rep_) if constexpr (PH(1)) {
                PHASE_IDS();
                LAS float* wfl = (LAS float*)lds;
                { const f32x4* wsrc = (const f32x4*)(wf_tab + (size_t)j * NH * DM);
                  for (int idx = tid; idx < NH * DM / 4; idx += NTHREADS) ((LAS f32x4*)wfl)[idx] = wsrc[idx]; }
                __syncthreads();
                for (int grp = gw; grp < S / 4; grp += NGW) {
                    const int t0 = grp * 4;
                    float acc[64]; float ss[4] = {0.f, 0.f, 0.f, 0.f};
#pragma unroll
                    for (int i = 0; i < 64; ++i) acc[i] = 0.f;
#pragma unroll 2
                    for (int jj = 0; jj < 8; ++jj) {
                        f32x4 xv[4];
#pragma unroll
                        for (int r = 0; r < 4; ++r) { const u32x2 raw = *(const u32x2*)(XB + (size_t)(t0 + r) * ALD + 256 * jj + 4 * lane);
                            xv[r] = (f32x4){__uint_as_float(raw.x << 16), __uint_as_float(raw.x & 0xffff0000u), __uint_as_float(raw.y << 16), __uint_as_float(raw.y & 0xffff0000u)};
                            ss[r] += (xv[r].x * xv[r].x + xv[r].y * xv[r].y) + (xv[r].z * xv[r].z + xv[r].w * xv[r].w); }
#pragma unroll
                        for (int h = 0; h < 16; ++h) { const f32x4 w = *(const LAS f32x4*)(wfl + h * DM + 256 * jj + 4 * lane);
#pragma unroll
                            for (int r = 0; r < 4; ++r) acc[r * 16 + h] += (xv[r].x * w.x + xv[r].y * w.y) + (xv[r].z * w.z + xv[r].w * w.w); }
                    }
#pragma unroll
                    for (int s = 32, n = 64; s >= 1; s >>= 1, n >>= 1) {
#pragma unroll
                        for (int i = 0; i < n / 2; ++i) { const bool up = (lane & s) != 0; const float a = acc[i], b = acc[i + n / 2];
                            const float send = up ? a : b, keep = up ? b : a; acc[i] = keep + __shfl_xor(send, s); } }
#pragma unroll
                    for (int r = 0; r < 4; ++r) ss[r] = wave_sum(ss[r]);
                    const int r = lane >> 4, h = lane & 15;
                    const float sr = (r == 0) ? ss[0] : (r == 1) ? ss[1] : (r == 2) ? ss[2] : ss[3];
                    const float f = acc[0] * __builtin_amdgcn_rsqf(sr * (1.0f / DM) + RMS_EPS) + b_f[j * NH + h];
                    const float lf = fminf(f, 0.f) - log1pf(expf(-fabsf(f)));
                    logf_[(size_t)h * S + t0 + r] = lf;
                }
                __syncthreads();
            }
            if constexpr (PH(2)) {
                pg8::Gemm g{(const char*)XB, (const char*)(ws + WS_WIN + (size_t)j * 24 * MiB), ALD, 3 * DM, DM, S / 256, 3 * DM / 256, 31, 0x7fffffff, 0u, 0u};
                LAS float* gtab = (LAS float*)(lds + 131072 + 2048 + 8192);
                { PHASE_IDS(); if (tid < HD) { gtab[tid] = gq[j * HD + tid] * QSCALE; gtab[HD + tid] = gk[j * HD + tid]; } }
                pg8::EpiQKV E{QKV, part, (LAS float*)(lds + 131072 + 2048), gtab};
                pg8::gemm_phase<pg8::EpiQKV, true>(lds, g, G, bx, E);
            }
            grid_sync();
            if (PH(3) && bx >= NH) {
                PHASE_IDS();
                CONV_LAYER(layer, (bx - NH) * 8 + wid, (G - NH) * 8, 0, 0x7fffffff, 8);
                __syncthreads();
            }
            if (PH(3) && bx < NH) {
                PHASE_IDS();
                LAS float* wtot = (LAS float*)lds; LAS float* gmx = (LAS float*)(lds + 64); LAS float* cl = (LAS float*)(lds + 2048);
                const int h = bx; const f32x4* lf = (const f32x4*)(logf_ + (size_t)h * S + tid * 16);
                float v[16];
#pragma unroll
                for (int i = 0; i < 4; ++i) { const f32x4 q = lf[i]; v[4 * i] = q.x; v[4 * i + 1] = q.y; v[4 * i + 2] = q.z; v[4 * i + 3] = q.w; }
#pragma unroll
                for (int i = 1; i < 16; ++i) v[i] += v[i - 1];
                const float total = v[15]; float incl = total;
#pragma unroll
                for (int o = 1; o < 64; o <<= 1) { const float t = __shfl_up(incl, o); if (lane >= o) incl += t; }
                if (lane == 63) wtot[wid] = incl;
                __syncthreads();
                float base = incl - total;
                for (int w = 0; w < wid; ++w) base += wtot[w];
                f32x4* co = (f32x4*)(cb + (size_t)h * S + tid * 16);
#pragma unroll
                for (int i = 0; i < 4; ++i) co[i] = (f32x4){-(base + v[4 * i]) * LOG2E, -(base + v[4 * i + 1]) * LOG2E, -(base + v[4 * i + 2]) * LOG2E, -(base + v[4 * i + 3]) * LOG2E};
#pragma unroll
                for (int i = 0; i < 16; ++i) cl[tid * 16 + i] = base + v[i];
                if (tid < HD) { gmx[tid] = fabsf(gq[j * HD + tid]); gmx[HD + tid] = fabsf(gk[j * HD + tid]); }
                __syncthreads();
                if (tid < S / 256) { float a = 0.f, b = 0.f;
                    for (int i = 0; i < HD; ++i) { a = fmaxf(a, gmx[i]); b = fmaxf(b, gmx[HD + i]); }
                    const float T = 2.04f * (11.3137085f * a * b) + 25.66f;
                    const int P0 = tid * 256; const float target = cl[P0] + T; int lo = 0, hi = P0;
                    while (lo < hi) { const int mid = (lo + hi) >> 1; if (cl[mid] <= target) hi = mid; else lo = mid + 1; }
                    jtab[h * (S / 256) + tid] = lo >> 6; }
            }
            grid_sync();
            for (int rep_ = 0; rep_ < REP_ATT; ++rep_) if constexpr (PH(4)) {
                char* alds = (char*)lds_raw;
                const bf16_t* Qb = QKV; const bf16_t* Kb = QKV + (size_t)NH * S * HD; const bf16_t* Vb = QKV + (size_t)2 * NH * S * HD;
                constexpr int TOTAL = NH * (S / 256); const int W = S;
                volatile LAS unsigned* sched = (volatile LAS unsigned*)(lds + LDS_BYTES - 32);
                unsigned* ctr = (unsigned*)args.ws + 3584 + 64 * j + 16 * rep_;
                int L = vcu;
                if (L < TOTAL) {
#define AREF(r, L_) do { const int h_ = (L_) & 15, qb_ = 31 - ((L_) >> 4);     (r).Q = Qb + ((size_t)h_ * S + (size_t)qb_ * 256) * HD; (r).K = Kb + (size_t)h_ * S * HD; (r).V = Vb + (size_t)h_ * S * HD; \
                              (r).CB = cb + (size_t)h_ * S; (r).O = OB + (size_t)qb_ * 256 * ALD + h_ * HD; (r).P0 = qb_ * 256; (r).jlo = jtab[h_ * 32 + qb_]; } while (0)
                    att::BlockRef cur, nxt; AREF(cur, L);
                    if (threadIdx.x == 0) sched[0] = atomicAdd(ctr, 1u) + (unsigned)G;
                    __syncthreads();
                    int Ln = (int)sched[0];
                    att::Seam Sm;
                    att::causal_prime(cur, W, alds, Sm);
                    for (int slot = 1;; slot ^= 1) {
                        const bool last = Ln >= TOTAL;
                        if (last) nxt = cur; else AREF(nxt, Ln);
                        if (threadIdx.x == 0) sched[slot] = atomicAdd(ctr, 1u) + (unsigned)G;
                        att::causal_block(cur, nxt, S, W, alds, Sm);
                        if (last) break;
                        cur = nxt; Ln = (int)sched[slot];
                    }
#undef AREF
                }
            }
            grid_sync();
            if constexpr (PH(5)) {
                pg8::Gemm g{(const char*)OB, (const char*)(ws + WS_WOUT + (size_t)j * 8 * MiB), ALD, DM, DM, S / 256, DM / 256, 31, 0x7fffffff, 0u, 0u};
                pg8::EpiResid<false> E{layer == 0 ? x_in : X, X, XB, part, nullptr, nullptr, true};
                pg8::gemm_phase<pg8::EpiResid<false>, false>(lds, g, G, bx, E);
            }
            grid_sync();
        } else {
            for (int rep_ = 0; rep_ < REP_Y; ++rep_) if constexpr (PH(6)) {
                PHASE_IDS();
                LAS f32x4* tile = (LAS f32x4*)lds;
                LAS float* rsl = (LAS float*)(lds + 47 * 128 * 16);
                const float* gm = mix_g + (size_t)layer * DM;
                u32x4 xv[6]; f32x4 g8a = (f32x4){0.f, 0.f, 0.f, 0.f}, g8b = g8a; float rsv = 0.f;
#pragma unroll
                for (int i = 0; i < 6; ++i) xv[i] = (u32x4){0u, 0u, 0u, 0u};
#define Y_LOAD(u_) do { const int ch_ = (u_) >> 2, gr_ = (((u_) & 3) + ((u_) >> 8)) & 3, t0_ = ch_ * 32, c0_ = gr_ * 512; \
                    g8a = *(const f32x4*)(gm + c0_ + 8 * (tid & 63)); g8b = *(const f32x4*)(gm + c0_ + 8 * (tid & 63) + 4); \
                    if (tid < 47) { const int row_ = t0_ - 15 + tid; rsv = row_ >= 0 ? row_rstd(part, row_) : 0.f; } \
                    _Pragma("unroll") for (int i = 0; i < 6; ++i) { const int idx = tid + NTHREADS * i, r = idx >> 6, q = idx & 63; const int row_ = t0_ - 15 + r; \
                        xv[i] = (r < 47 && row_ >= 0) ? *(const u32x4*)(XB + (size_t)row_ * ALD + c0_ + 8 * q) : (u32x4){0u, 0u, 0u, 0u}; } } while (0)
                int u = vcu; if (u < 1024) Y_LOAD(u);
                while (u < 1024) {
                    const int chunk = u >> 2, grp = ((u & 3) + (u >> 8)) & 3, t0 = chunk * 32, c0 = grp * 512, w = 2 << grp;
                    if (tid < 47) rsl[tid] = rsv;
#pragma unroll
                    for (int i = 0; i < 6; ++i) { const int idx = tid + NTHREADS * i, r = idx >> 6, q = idx & 63;
                        if (r < 47) { const u32x4 b = xv[i];
                            tile[r * 128 + 2 * q] = (f32x4){__uint_as_float(b.x << 16), __uint_as_float(b.x & 0xffff0000u), __uint_as_float(b.y << 16), __uint_as_float(b.y & 0xffff0000u)} * g8a;
                            tile[r * 128 + 2 * q + 1] = (f32x4){__uint_as_float(b.z << 16), __uint_as_float(b.z & 0xffff0000u), __uint_as_float(b.w << 16), __uint_as_float(b.w & 0xffff0000u)} * g8b; } }
                    __syncthreads();
                    const int un = u + G; if (un < 1024) Y_LOAD(un);
                    const int cq = tid & 127, tb = tid >> 7;
                    f32x4 s = (f32x4){0.f, 0.f, 0.f, 0.f};
                    for (int i = 1; i < w; ++i) s += tile[(tb * 8 + 15 - i) * 128 + cq] * rsl[tb * 8 + 15 - i];
#pragma unroll 1
                    for (int k = 0; k < 8; ++k) { const int tl = tb * 8 + k;
                        const f32x4 hc = tile[(tl + 15) * 128 + cq] * rsl[tl + 15];
                        s += hc;
                        const int t = t0 + tl; const int cnt = (t + 1 < w) ? t + 1 : w;
                        const f32x4 y = s * (1.0f / (float)cnt) - hc;
                        s -= tile[(tl + 16 - w) * 128 + cq] * rsl[tl + 16 - w];
                        u32x2 o; o.x = cvt_pk_bf16(y.x, y.y); o.y = cvt_pk_bf16(y.z, y.w);
                        *(u32x2*)(OB + (size_t)t * ALD + c0 + 4 * cq) = o; }
                    __syncthreads();
                    u = un;
                }
#undef Y_LOAD
            }
            grid_sync();
            if constexpr (PH(7)) {
                pg8::Gemm g{(const char*)OB, (const char*)(ws + WS_WPOOL + (size_t)j * 2 * MiB), ALD, 512, 512, S / 256, DM / 256, 1, 1, 1024u, 512u * 512u * 2u};
                pg8::EpiResid<true> E{X, X, XB, part, pool_b + (size_t)j * DM, pool_s + (size_t)j * DM, true};
                pg8::gemm_phase<pg8::EpiResid<true>, false>(lds, g, G, bx, E);
            }
            grid_sync();
        }
        for (int rep_ = 0; rep_ < REP_GU; ++rep_) if constexpr (PH(8)) {
            pg8::Gemm g{(const char*)XB, (const char*)(ws + WS_WGU + (size_t)layer * 44 * MiB), ALD, 2 * FF, DM, S / 256, 2 * FF / 256, 31, 0x7fffffff, 0u, 0u};
            pg8::EpiGateUp E{HB, part};
            pg8::gemm_phase<pg8::EpiGateUp, true>(lds, g, G, bx, E);
            {
                PHASE_IDS();
                const int rem = ((S / 256) * (2 * FF / 256)) % G, nidle = rem ? G - rem : G, idx = rem ? bx - rem : bx;
                if (idx >= 0) {
                    constexpr int L2_ITEMS = 1536 + 2816, L2_CUT = L2_ITEMS - 940;
                    if (layer + 1 < NLAYER) CONV_LAYER(layer + 1, idx * 8 + wid, nidle * 8, 0, (layer == 1 ? L2_CUT : 0x7fffffff), 3);
                    if (layer == 0) CONV_LAYER(2, idx * 8 + wid, nidle * 8, L2_CUT, 0x7fffffff, 3);
                    CONV_LAYER(layer, nidle * 8 - 1 - (idx * 8 + wid), nidle * 8, 0, 0x7fffffff, 4);
                }
                __syncthreads();
            }
        }
        grid_sync();
        if constexpr (PH(9)) {
            pg8::Gemm g{(const char*)HB, (const char*)(ws + WS_WDN + (size_t)layer * 22 * MiB), FF, DM, FF, S / 256, DM / 256, 31, 0x7fffffff, 0u, 0u};
            pg8::EpiResid<false> E{X, X, XB, part, nullptr, nullptr, layer + 1 < NLAYER};
            pg8::gemm_phase<pg8::EpiResid<false>, false>(lds, g, G, bx, E);
        }
        if (layer + 1 < NLAYER) grid_sync();
    }
}

extern "C" void kernel_launch(void* const* d_in, const int* in_sizes, int n_in, void* d_out, int out_size, void* d_ws, size_t ws_size, hipStream_t stream) {
    static int grid = 0;
    if (grid == 0) {
        if (n_in != 13 || out_size != S * DM || ws_size < WS_END) { fprintf(stderr, "kernel_launch: unexpected shapes (n_in %d out %d ws %zu)\n", n_in, out_size, ws_size); grid = -1; return; }
        int dev = 0, cus = 0, per_cu = 0;
        hipGetDevice(&dev); hipDeviceGetAttribute(&cus, hipDeviceAttributeMultiprocessorCount, dev);
        if (hipFuncSetAttribute((const void*)fwd_megakernel, hipFuncAttributeMaxDynamicSharedMemorySize, LDS_BYTES) != hipSuccess) { fprintf(stderr, "kernel_launch: hipFuncSetAttribute failed\n"); grid = -1; return; }
        if (hipOccupancyMaxActiveBlocksPerMultiprocessor(&per_cu, (const void*)fwd_megakernel, NTHREADS, LDS_BYTES) != hipSuccess || per_cu < 1) { fprintf(stderr, "kernel_launch: occupancy query says %d\n", per_cu); per_cu = 1; }
        (void)hipGetLastError();
        grid = cus * 1;
        fprintf(stderr, "kernel_launch: cus %d per_cu %d grid %d\n", cus, per_cu, grid);
    }
    if (grid < 0) return;
    if (hipMemsetAsync(d_ws, 0, 16384, stream) != hipSuccess) { fprintf(stderr, "kernel_launch: memset failed\n"); return; }
    Args a{};
    for (int i = 0; i < 13; ++i) a.in[i] = (const float*)d_in[i];
    a.out = (float*)d_out; a.ws = (unsigned char*)d_ws;
    void* kargs[] = {&a};
    hipError_t e = hipLaunchCooperativeKernel((const void*)fwd_megakernel, dim3(grid), dim3(NTHREADS), kargs, LDS_BYTES, stream);
    if (e != hipSuccess) fprintf(stderr, "cooperative launch failed: %s (grid %d)\n", hipGetErrorString(e), grid);
}
```
